# Optimizing an MI355X kernel written in HIP

```python
import math
import jax, jax.numpy as jnp
from jax import lax
import numpy as np

D_MODEL = 1024
BATCH = 32
SEQ = 256
DEPTH = 4
DEC_BATCH = 4
DEC_SEQ = 2048
PAST_LEN = 256

GRID_W = 64
N_MIXERS = 2
N_SSM_LAYERS = (DEPTH + 1) // 2
N_POOL_LAYERS = DEPTH // 2
SSM_GROUP = 16
SSM_GROUPS = D_MODEL // SSM_GROUP
SSM_STATE = 64
N_DIRS = 2
POOL_WINDOWS = (2, 4, 8, 16)
N_POOL_GROUPS = len(POOL_WINDOWS)
POOL_GROUP = D_MODEL // N_POOL_GROUPS
D_FF = -(-8 * D_MODEL // (3 * 256)) * 256
DEEPNORM_ALPHA = (2 * DEPTH) ** 0.25
DEEPNORM_BETA = (8 * DEPTH) ** -0.25
LN_EPS = 1e-5
DT_MIN = 0.001
DT_MAX = 0.1

kernel_name = 'hybrid_s5_pool_prefix_diffusion_step'

F32 = jnp.float32


def layer_norm(x, g, b):
    xf = x.astype(F32)
    mu = jnp.mean(xf, axis=-1, keepdims=True)
    var = jnp.mean(jnp.square(xf - mu), axis=-1, keepdims=True)
    y = (xf - mu) * lax.rsqrt(var + LN_EPS)
    return (y * g + b).astype(x.dtype)


def ada_mod(cond, w, b):
    m = (jax.nn.silu(cond) @ w + b)[..., None, :]
    return jnp.split(m, 6, axis=-1)


def modulate(x, shift, scale):
    return x * (1 + scale) + shift


def s5_discretize(a_re, a_im, log_step, b_re, b_im):
    a_re = a_re.astype(F32)
    a_im = a_im.astype(F32)
    b_re = b_re.astype(F32)
    b_im = b_im.astype(F32)
    dt = jnp.exp(log_step.astype(F32))[:, None]
    mag = jnp.exp(a_re * dt)
    ang = a_im * dt
    ab_re = mag * jnp.cos(ang)
    ab_im = mag * jnp.sin(ang)
    den = jnp.square(a_re) + jnp.square(a_im)
    num_re = ab_re - 1.0
    coef_re = (num_re * a_re + ab_im * a_im) / den
    coef_im = (ab_im * a_re - num_re * a_im) / den
    bb_re = coef_re[..., None] * b_re - coef_im[..., None] * b_im
    bb_im = coef_re[..., None] * b_im + coef_im[..., None] * b_re
    return ab_re, ab_im, bb_re, bb_im


def _linear_recurrence_combine(e1, e2):
    a1r, a1i, b1r, b1i = e1
    a2r, a2i, b2r, b2i = e2
    return (a2r * a1r - a2i * a1i,
            a2r * a1i + a2i * a1r,
            a2r * b1r - a2i * b1i + b2r,
            a2r * b1i + a2i * b1r + b2i)


def s5_scan(u, ab_re, ab_im, bb_re, bb_im, h0_re, h0_im, reverse):
    bu_re = jnp.einsum('blgh,gph->blgp', u, bb_re)
    bu_im = jnp.einsum('blgh,gph->blgp', u, bb_im)
    first = -1 if reverse else 0
    h0_re = h0_re.astype(F32)
    h0_im = h0_im.astype(F32)
    bu_re = bu_re.at[:, first].add(ab_re * h0_re - ab_im * h0_im)
    bu_im = bu_im.at[:, first].add(ab_re * h0_im + ab_im * h0_re)
    a_re = jnp.broadcast_to(ab_re, bu_re.shape)
    a_im = jnp.broadcast_to(ab_im, bu_re.shape)
    _, _, s_re, s_im = lax.associative_scan(
        _linear_recurrence_combine, (a_re, a_im, bu_re, bu_im), axis=1, reverse=reverse)
    last = 0 if reverse else -1
    return s_re, s_im, s_re[:, last], s_im[:, last]


def s5_mixer(h, a_re, a_im, log_step, b_re, b_im, c_re, c_im, d_skip, glu_w, glu_b, h0_re, h0_im):
    bsz, seq_len, _ = h.shape
    u = h.astype(F32).reshape(bsz, seq_len, SSM_GROUPS, SSM_GROUP)
    y = u * d_skip.astype(F32).reshape(SSM_GROUPS, SSM_GROUP)
    fin_re, fin_im = [], []
    for d in range(N_DIRS):
        ab_re, ab_im, bb_re, bb_im = s5_discretize(a_re[d], a_im[d], log_step[d], b_re[d], b_im[d])
        s_re, s_im, f_re, f_im = s5_scan(u, ab_re, ab_im, bb_re, bb_im,
                                         h0_re[:, d], h0_im[:, d], reverse=(d == 1))
        y = y + (jnp.einsum('blgp,ghp->blgh', s_re, c_re[d].astype(F32))
                 - jnp.einsum('blgp,ghp->blgh', s_im, c_im[d].astype(F32)))
        fin_re.append(f_re)
        fin_im.append(f_im)
    y = jax.nn.gelu(y.reshape(bsz, seq_len, D_MODEL))
    v = y @ glu_w + glu_b
    val, gate = jnp.split(v, 2, axis=-1)
    out = val * jax.nn.sigmoid(gate)
    return out.astype(h.dtype), jnp.stack(fin_re, axis=1), jnp.stack(fin_im, axis=1)


def _window_bounds(n, k):
    pos = jnp.arange(n)
    lo = jnp.clip(pos - k // 2, 0, n)
    hi = jnp.clip(pos - k // 2 + k, 0, n)
    return lo, hi


def pool_seq(x, k):
    seq_len = x.shape[1]
    s = jnp.pad(jnp.cumsum(x, axis=1), ((0, 0), (1, 0), (0, 0)))
    lo, hi = _window_bounds(seq_len, k)
    cnt = (hi - lo).astype(F32)[None, :, None]
    return (jnp.take(s, hi, axis=1) - jnp.take(s, lo, axis=1)) / cnt


def pool_grid(x, k):
    bsz, seq_len, ch = x.shape
    rows = seq_len // GRID_W
    g = x.reshape(bsz, rows, GRID_W, ch)
    s = jnp.cumsum(jnp.cumsum(g, axis=1), axis=2)
    s = jnp.pad(s, ((0, 0), (1, 0), (1, 0), (0, 0)))
    rlo, rhi = _window_bounds(rows, k)
    clo, chi = _window_bounds(GRID_W, k)
    s_rhi = jnp.take(s, rhi, axis=1)
    s_rlo = jnp.take(s, rlo, axis=1)
    tot = (jnp.take(s_rhi, chi, axis=2) - jnp.take(s_rhi, clo, axis=2)
           - jnp.take(s_rlo, chi, axis=2) + jnp.take(s_rlo, clo, axis=2))
    cnt = ((rhi - rlo)[:, None] * (chi - clo)[None, :]).astype(F32)[None, :, :, None]
    return (tot / cnt).reshape(bsz, seq_len, ch)


def pool_mixer(h, w_groups, scale, grid):
    hf = h.astype(F32)
    outs = []
    for gi, k in enumerate(POOL_WINDOWS):
        xg = hf[..., gi * POOL_GROUP:(gi + 1) * POOL_GROUP]
        pooled = pool_grid(xg, k) if grid else pool_seq(xg, k)
        outs.append((pooled - xg) @ w_groups[gi])
    return (jnp.concatenate(outs, axis=-1) * scale).astype(h.dtype)


def swiglu(h, w_gate, w_up, w_down):
    return (jax.nn.silu(h @ w_gate) * (h @ w_up)) @ w_down


def setup_inputs(seed: int = 0) -> dict:
    key = jax.random.key(seed)
    ks = jax.random.split(key, 32)
    nrm = jax.random.normal
    G, P, HG = SSM_GROUPS, SSM_STATE, SSM_GROUP
    x_prompt = nrm(ks[0], (BATCH, SEQ, D_MODEL), F32)
    x_sample = nrm(ks[1], (DEC_BATCH, DEC_SEQ, D_MODEL), F32)
    state_ssm_re = 0.1 * nrm(ks[2], (DEC_BATCH, N_SSM_LAYERS, N_DIRS, G, P), F32)
    state_ssm_im = 0.1 * nrm(ks[3], (DEC_BATCH, N_SSM_LAYERS, N_DIRS, G, P), F32)
    c = nrm(ks[4], (DEC_BATCH, D_MODEL), F32)
    c_ctx = nrm(ks[5], (D_MODEL,), F32)
    ada_w = nrm(ks[6], (DEPTH, D_MODEL, 6 * D_MODEL), F32) * D_MODEL ** -0.5
    ada_b = 0.01 * nrm(ks[7], (DEPTH, 6 * D_MODEL), F32)
    ln_g = 1.0 + 0.01 * nrm(ks[8], (DEPTH, 2, D_MODEL), F32)
    ln_b = 0.01 * nrm(ks[9], (DEPTH, 2, D_MODEL), F32)
    ssm_a_re = -0.5 + 0.01 * nrm(ks[10], (N_SSM_LAYERS, N_DIRS, G, P), F32)
    ssm_a_im = (math.pi * jnp.arange(P, dtype=F32)
                + 0.01 * nrm(ks[11], (N_SSM_LAYERS, N_DIRS, G, P), F32))
    ssm_log_step = jax.random.uniform(ks[12], (N_SSM_LAYERS, N_DIRS, G), F32,
                                      minval=math.log(DT_MIN), maxval=math.log(DT_MAX))
    ssm_b_re = nrm(ks[13], (N_SSM_LAYERS, N_DIRS, G, P, HG), F32) * (2 * HG) ** -0.5
    ssm_b_im = nrm(ks[14], (N_SSM_LAYERS, N_DIRS, G, P, HG), F32) * (2 * HG) ** -0.5
    ssm_c_re = nrm(ks[15], (N_SSM_LAYERS, N_DIRS, G, HG, P), F32) * (2 * P) ** -0.5
    ssm_c_im = nrm(ks[16], (N_SSM_LAYERS, N_DIRS, G, HG, P), F32) * (2 * P) ** -0.5
    ssm_d = nrm(ks[17], (N_SSM_LAYERS, D_MODEL), F32)
    ssm_glu_w = nrm(ks[18], (N_SSM_LAYERS, D_MODEL, 2 * D_MODEL), F32) * (D_MODEL ** -0.5 * DEEPNORM_BETA)
    ssm_glu_b = 0.01 * nrm(ks[19], (N_SSM_LAYERS, 2 * D_MODEL), F32)
    pool_w = nrm(ks[20], (N_POOL_LAYERS, N_POOL_GROUPS, POOL_GROUP, POOL_GROUP), F32) * (POOL_GROUP ** -0.5 * DEEPNORM_BETA)
    pool_scale = 1.0 + 0.01 * nrm(ks[21], (N_POOL_LAYERS, D_MODEL), F32)
    ffn_w_gate = nrm(ks[22], (DEPTH, D_MODEL, D_FF), F32) * D_MODEL ** -0.5
    ffn_w_up = nrm(ks[23], (DEPTH, D_MODEL, D_FF), F32) * D_MODEL ** -0.5
    ffn_w_down = nrm(ks[24], (DEPTH, D_FF, D_MODEL), F32) * (D_FF ** -0.5 * DEEPNORM_BETA)
    return {'x_prompt': x_prompt, 'x_sample': x_sample,
            'state_ssm_re': state_ssm_re, 'state_ssm_im': state_ssm_im,
            'c': c, 'c_ctx': c_ctx, 'ada_w': ada_w, 'ada_b': ada_b,
            'ln_g': ln_g, 'ln_b': ln_b,
            'ssm_a_re': ssm_a_re, 'ssm_a_im': ssm_a_im, 'ssm_log_step': ssm_log_step,
            'ssm_b_re': ssm_b_re, 'ssm_b_im': ssm_b_im, 'ssm_c_re': ssm_c_re, 'ssm_c_im': ssm_c_im,
            'ssm_d': ssm_d, 'ssm_glu_w': ssm_glu_w, 'ssm_glu_b': ssm_glu_b,
            'pool_w': pool_w, 'pool_scale': pool_scale,
            'ffn_w_gate': ffn_w_gate, 'ffn_w_up': ffn_w_up, 'ffn_w_down': ffn_w_down}


def reference(x_prompt, x_sample, state_ssm_re, state_ssm_im, c, c_ctx, ada_w, ada_b,
              ln_g, ln_b, ssm_a_re, ssm_a_im, ssm_log_step, ssm_b_re, ssm_b_im,
              ssm_c_re, ssm_c_im, ssm_d, ssm_glu_w, ssm_glu_b, pool_w, pool_scale,
              ffn_w_gate, ffn_w_up, ffn_w_down):
    xc = x_prompt
    xl = x_sample
    new_re, new_im = [], []
    for i in range(DEPTH):
        sh1c, sc1c, g1c, sh2c, sc2c, g2c = ada_mod(c_ctx, ada_w[i], ada_b[i])
        sh1l, sc1l, g1l, sh2l, sc2l, g2l = ada_mod(c, ada_w[i], ada_b[i])
        hc = modulate(xc, sh1c, sc1c)
        hl = modulate(xl, sh1l, sc1l)
        j = i // N_MIXERS
        if i % N_MIXERS == 0:
            params = (ssm_a_re[j], ssm_a_im[j], ssm_log_step[j], ssm_b_re[j], ssm_b_im[j],
                      ssm_c_re[j], ssm_c_im[j], ssm_d[j], ssm_glu_w[j], ssm_glu_b[j])
            zeros = jnp.zeros((xc.shape[0], N_DIRS, SSM_GROUPS, SSM_STATE), F32)
            oc, fin_re, fin_im = s5_mixer(hc, *params, zeros, zeros)
            ol, _, _ = s5_mixer(hl, *params, state_ssm_re[:, j], state_ssm_im[:, j])
            new_re.append(fin_re)
            new_im.append(fin_im)
        else:
            oc = pool_mixer(hc, pool_w[j], pool_scale[j], grid=False)
            ol = pool_mixer(hl, pool_w[j], pool_scale[j], grid=True)
        xc = layer_norm(DEEPNORM_ALPHA * xc + g1c * oc, ln_g[i, 0], ln_b[i, 0])
        xl = layer_norm(DEEPNORM_ALPHA * xl + g1l * ol, ln_g[i, 0], ln_b[i, 0])
        fc = swiglu(modulate(xc, sh2c, sc2c), ffn_w_gate[i], ffn_w_up[i], ffn_w_down[i])
        fl = swiglu(modulate(xl, sh2l, sc2l), ffn_w_gate[i], ffn_w_up[i], ffn_w_down[i])
        xc = layer_norm(DEEPNORM_ALPHA * xc + g2c * fc, ln_g[i, 1], ln_b[i, 1])
        xl = layer_norm(DEEPNORM_ALPHA * xl + g2l * fl, ln_g[i, 1], ln_b[i, 1])
    new_state_ssm_re = jnp.stack(new_re, axis=1).astype(state_ssm_re.dtype)
    new_state_ssm_im = jnp.stack(new_im, axis=1).astype(state_ssm_im.dtype)
    return (xc, xl, new_state_ssm_re, new_state_ssm_im)
```

```cpp
#include <hip/hip_runtime.h>
#include <hip/hip_cooperative_groups.h>
#include <cstdio>
namespace cg = cooperative_groups;

#ifndef MULTI_LAUNCH
#define MULTI_LAUNCH 0
#endif
#ifndef REPMASK
#define REPMASK 0
#endif

#define LAS __attribute__((address_space(3)))
typedef unsigned short bf16_t;
typedef short bf16x8 __attribute__((ext_vector_type(8)));
typedef float f32x2 __attribute__((ext_vector_type(2)));
typedef float f32x4 __attribute__((ext_vector_type(4)));
typedef float f32x16 __attribute__((ext_vector_type(16)));
typedef unsigned u32x2 __attribute__((ext_vector_type(2)));
typedef unsigned u32x4 __attribute__((ext_vector_type(4)));

constexpr int D = 1024, NTOK = 16384, NCTX = 8192, DFF = 2816, NFF1 = 5632;
constexpr float ALPHA = 1.681792830507429f;
constexpr float LN_EPS = 1e-5f;
constexpr int LDS_BYTES = 131072 + 16;
constexpr int NPH = 30;
constexpr int XCD_BAR_WORDS_C = 3456;
constexpr int LDS_ST_OFF = 131072;

constexpr size_t WS_W1 = 0;
constexpr size_t WS_W2 = WS_W1 + (size_t)4 * 5632 * 1024 * 2;
constexpr size_t WS_WG = WS_W2 + (size_t)4 * 1024 * 2816 * 2;
constexpr size_t WS_WP = WS_WG + (size_t)2 * 2048 * 1024 * 2;
constexpr size_t WS_MOD = WS_WP + (size_t)2 * 4 * 256 * 256 * 2;
constexpr size_t WS_ST = WS_MOD + (size_t)4 * 5 * 6144 * 4;
constexpr size_t WS_Z = WS_ST + (size_t)NTOK * 64 * 4;
constexpr size_t WS_Y = WS_Z + (size_t)NTOK * D * 4;
constexpr size_t WS_P = WS_Y + (size_t)2 * NTOK * D * 4;
constexpr size_t WS_Q = WS_P + (size_t)NTOK * D * 2;
constexpr size_t WS_BAR = WS_Q + (size_t)NTOK * D * 2;
constexpr size_t WS_E = WS_BAR + (size_t)XCD_BAR_WORDS_C * 4;
constexpr size_t WS_END = WS_E + (size_t)32 * 2 * 64 * 64 * 8;

struct Params {
    const float* in[25];
    float* out;
    unsigned char* ws;
    int ph_lo, ph_hi;
};

__device__ __forceinline__ unsigned cvt_pk_bf16(float lo, float hi) { unsigned r; asm("v_cvt_pk_bf16_f32 %0, %1, %2" : "=v"(r) : "v"(lo), "v"(hi)); return r; }
__device__ __forceinline__ float bf_lo(unsigned w) { return __uint_as_float(w << 16); }
__device__ __forceinline__ float bf_hi(unsigned w) { return __uint_as_float(w & 0xffff0000u); }
__device__ __forceinline__ float sigmoidf_(float x) { return __builtin_amdgcn_rcpf(1.0f + __expf(-x)); }
__device__ __forceinline__ float gelu_tanh(float x) { const float a = 1.5957691216057308f * (x + 0.044715f * x * x * x); return x * sigmoidf_(a); }
__device__ __forceinline__ int opaque_tid() { int t = threadIdx.x; asm volatile("" : "+v"(t)); return t; }
__device__ __forceinline__ int opaque_bid() { int b = blockIdx.x; asm volatile("" : "+s"(b)); return b; }
__device__ __forceinline__ int opaque_s(int v) { asm volatile("" : "+s"(v)); return v; }
__device__ __forceinline__ int cond_of_row(int row) { return row < NCTX ? 0 : 1 + ((row - NCTX) >> 11); }


#define XB_TMO      128
#define XB_XCNT(j)  (256  + 64 * (j))
#define XB_XSUB(j)  (1280 + 64 * (j))
#define XB_XGEN(j)  (2304 + 64 * (j))
#define XB_TOP      3328
#define XB_TOPGEN   3392
#define XCD_BAR_WORDS 3456
#define XB_SPIN_CAP (1u << 20)
__device__ __forceinline__ unsigned xb_ld(unsigned* p)              { return __hip_atomic_load(p, __ATOMIC_RELAXED, __HIP_MEMORY_SCOPE_AGENT); }
__device__ __forceinline__ unsigned xb_add(unsigned* p, unsigned v) { return __hip_atomic_fetch_add(p, v, __ATOMIC_RELAXED, __HIP_MEMORY_SCOPE_AGENT); }
__device__ __forceinline__ unsigned xb_xcc_id() { return (unsigned)__builtin_amdgcn_s_getreg((3 << 11) | 20) & 0xFu; }
#define XB_SPIN(cond, bar) do { unsigned _sp = 0; while (cond) { __builtin_amdgcn_s_sleep(1); \
    if ((++_sp & 255u) == 0u) { if (xb_ld(&(bar)[XB_TMO])) break; if (_sp > XB_SPIN_CAP) { atomicAdd(&(bar)[XB_TMO], 1u); break; } } } } while (0)
struct XcdBarrier { unsigned* bar; unsigned x; volatile LAS unsigned* st; };
__device__ __forceinline__ XcdBarrier xcd_barrier_post(unsigned* bar, volatile LAS unsigned* st) {
    XcdBarrier b; b.bar = bar; b.x = xb_xcc_id(); b.st = st;
    if (threadIdx.x == 0) (void)xb_add(&bar[XB_XCNT(b.x)], 1u);
    return b;
}
__device__ __forceinline__ void xcd_barrier_complete(unsigned* bar, unsigned x, unsigned& nloc, unsigned& nx) {
    const unsigned G = gridDim.x * gridDim.y * gridDim.z;
    unsigned sum, cnt, mine, sp = 0u;
    for (;;) {
        sum = 0u; cnt = 0u; mine = 0u;
#pragma unroll
        for (unsigned j = 0; j < 16; ++j) { const unsigned c = xb_ld(&bar[XB_XCNT(j)]); sum += c; cnt += (c > 0u) ? 1u : 0u; mine = (j == x) ? c : mine; }
        if (sum == G) break;
        __builtin_amdgcn_s_sleep(1);
        if ((++sp & 255u) == 0u) { if (xb_ld(&bar[XB_TMO])) break; if (sp > XB_SPIN_CAP) { atomicAdd(&bar[XB_TMO], 1u); break; } }
    }
    nloc = mine > 0u ? mine : 1u; nx = cnt > 0u ? cnt : 1u;
}
__device__ __forceinline__ void xcd_barrier(const XcdBarrier& b) {
    asm volatile("s_waitcnt vmcnt(0)" ::: "memory");
    __syncthreads();
    if (threadIdx.x == 0) {
        unsigned* bar = b.bar;
        __builtin_amdgcn_s_waitcnt(0);
        unsigned nloc = b.st[0], nx = b.st[1];
        if (nloc == 0u) { xcd_barrier_complete(bar, b.x, nloc, nx); b.st[0] = nloc; b.st[1] = nx; }
        const unsigned old = xb_add(&bar[XB_XSUB(b.x)], 1u);
        const unsigned gen = old / nloc;
        if (old + 1u == (gen + 1u) * nloc) {
            __builtin_amdgcn_fence(__ATOMIC_RELEASE, "agent");
            asm volatile("s_waitcnt vmcnt(0)" ::: "memory");
            const unsigned og = xb_add(&bar[XB_TOP], 1u);
            const unsigned tg = og / nx;
            if (og + 1u == (tg + 1u) * nx) xb_add(&bar[XB_TOPGEN], 1u);
            else XB_SPIN(xb_ld(&bar[XB_TOPGEN]) == tg, bar);
            __builtin_amdgcn_fence(__ATOMIC_ACQUIRE, "agent");
            xb_add(&bar[XB_XGEN(b.x)], 1u);
            asm volatile("s_waitcnt vmcnt(0)" ::: "memory");
        } else {
            XB_SPIN(xb_ld(&bar[XB_XGEN(b.x)]) == gen, bar);
            __builtin_amdgcn_fence(__ATOMIC_ACQUIRE, "agent");
            asm volatile("s_waitcnt vmcnt(0)" ::: "memory");
        }
    }
    __syncthreads();
}

__device__ void adaln_item(const Params& p, int it, LAS float* lds) {
    const int tid = opaque_tid();
    const int layer = it / 96, c0 = (it % 96) * 64;
    LAS float* s = lds;
    LAS float* red = lds + 5120;
    for (int e = tid; e < 5120; e += 512) { const int cnd = e >> 10, k = e & 1023; const float v = cnd == 0 ? p.in[5][k] : p.in[4][(cnd - 1) * 1024 + k]; s[e] = v * sigmoidf_(v); }
    __syncthreads();
    const int cgp = tid & 15, ks = tid >> 4;
    f32x4 acc[5];
#pragma unroll
    for (int c = 0; c < 5; ++c) acc[c] = (f32x4){0.f, 0.f, 0.f, 0.f};
    const float* base = p.in[6] + (size_t)layer * 1024 * 6144 + c0 + cgp * 4;
#pragma unroll 8
    for (int kk = 0; kk < 32; ++kk) { const int k = ks * 32 + kk; const f32x4 w = *(const f32x4*)(base + (size_t)k * 6144);
#pragma unroll
        for (int c = 0; c < 5; ++c) acc[c] += s[c * 1024 + k] * w; }
#pragma unroll
    for (int c = 0; c < 5; ++c) *(LAS f32x4*)(red + (ks * 5 + c) * 64 + cgp * 4) = acc[c];
    __syncthreads();
    if (tid < 320) { const int cnd = tid >> 6, col = tid & 63; float a = p.in[7][layer * 6144 + c0 + col];
        for (int k2 = 0; k2 < 32; ++k2) a += red[(k2 * 5 + cnd) * 64 + col];
        ((float*)(p.ws + WS_MOD))[(layer * 5 + cnd) * 6144 + c0 + col] = a; }
    __syncthreads();
}

struct TJob { const float* srcA; const float* srcB; bf16_t* dst; int src_ld, dst_ld, k0, c0; bool inter; };
__device__ __forceinline__ TJob decode_job(const Params& p, int idx) {
    TJob j;
    if (idx < 5632) { const int layer = idx / 1408, r = idx % 1408, kt = r / 88, ct = r % 88;
        j.srcA = p.in[22] + (size_t)layer * 1024 * 2816; j.srcB = p.in[23] + (size_t)layer * 1024 * 2816; j.src_ld = 2816; j.k0 = kt * 64; j.c0 = ct * 64; j.inter = true; j.dst = (bf16_t*)(p.ws + WS_W1) + (size_t)layer * 5632 * 1024; j.dst_ld = 1024;
    } else if (idx < 8448) { const int r0 = idx - 5632, layer = r0 / 704, r = r0 % 704, kt = r / 16, ct = r % 16;
        j.srcA = p.in[24] + (size_t)layer * 2816 * 1024; j.srcB = j.srcA; j.src_ld = 1024; j.k0 = kt * 64; j.c0 = ct * 64; j.inter = false; j.dst = (bf16_t*)(p.ws + WS_W2) + (size_t)layer * 1024 * 2816; j.dst_ld = 2816;
    } else if (idx < 9472) { const int r0 = idx - 8448, jj = r0 / 512, r = r0 % 512, kt = r / 32, ct = r % 32;
        j.srcA = p.in[18] + (size_t)jj * 1024 * 2048; j.srcB = j.srcA + 1024; j.src_ld = 2048; j.k0 = kt * 64; j.c0 = ct * 64; j.inter = true; j.dst = (bf16_t*)(p.ws + WS_WG) + (size_t)jj * 2048 * 1024; j.dst_ld = 1024;
    } else { const int r0 = idx - 9472, jg = r0 / 16, r = r0 % 16, kt = r / 4, ct = r % 4;
        j.srcA = p.in[20] + (size_t)jg * 65536; j.srcB = j.srcA; j.src_ld = 256; j.k0 = kt * 64; j.c0 = ct * 64; j.inter = false; j.dst = (bf16_t*)(p.ws + WS_WP) + (size_t)jg * 65536; j.dst_ld = 256; }
    return j;
}
__device__ void phase_w0(const Params& p, LAS unsigned char* lds8) {
    LAS float* lds = (LAS float*)lds8;
    const int NADA = 384, NJ = 9600, G = gridDim.x;
    const int bid = opaque_bid();
    for (int it = bid; it < NADA; it += G) adaln_item(p, it, lds);
    const int tid = opaque_tid(), l64 = tid & 63, kk0 = tid >> 6, c = tid >> 3, ks = tid & 7;
    for (int base = bid; base < NJ; base += 4 * G) {
        float vals[4][8]; int cl[4];
#pragma unroll
        for (int q = 0; q < 4; ++q) { const int idx = base + q * G;
            if (idx < NJ) { const TJob j = decode_job(p, idx); const float* sp;
                if (j.inter) { const int n = l64 >> 5, oo = l64 & 31; sp = (n ? j.srcB : j.srcA) + (j.c0 >> 1) + oo; cl[q] = (oo >> 4) * 32 + n * 16 + (oo & 15); }
                else { sp = j.srcA + j.c0 + l64; cl[q] = l64; }
#pragma unroll
                for (int i8 = 0; i8 < 8; ++i8) vals[q][i8] = sp[(size_t)(j.k0 + kk0 + i8 * 8) * j.src_ld]; } }
#pragma unroll
        for (int q = 0; q < 4; ++q) { if (base + q * G < NJ) {
#pragma unroll
                for (int i8 = 0; i8 < 8; ++i8) lds[q * 4160 + (kk0 + i8 * 8) * 65 + cl[q]] = vals[q][i8]; } }
        __syncthreads();
#pragma unroll
        for (int q = 0; q < 4; ++q) { const int idx = base + q * G;
            if (idx < NJ) { const TJob j = decode_job(p, idx); float v[8];
#pragma unroll
                for (int e = 0; e < 8; ++e) v[e] = lds[q * 4160 + (ks * 8 + e) * 65 + c];
                u32x4 w; w.x = cvt_pk_bf16(v[0], v[1]); w.y = cvt_pk_bf16(v[2], v[3]); w.z = cvt_pk_bf16(v[4], v[5]); w.w = cvt_pk_bf16(v[6], v[7]);
                *(u32x4*)(j.dst + (size_t)(j.c0 + c) * j.dst_ld + j.k0 + ks * 8) = w; } }
        __syncthreads();
    }
}

__device__ __forceinline__ void store_bf16x8(bf16_t* dst, const f32x4 a, const f32x4 b) {
    u32x4 w; w.x = cvt_pk_bf16(a[0], a[1]); w.y = cvt_pk_bf16(a[2], a[3]); w.z = cvt_pk_bf16(b[0], b[1]); w.w = cvt_pk_bf16(b[2], b[3]);
    *(u32x4*)dst = w;
}

__device__ void phase_prep0(const Params& p) {
    const int tid_ = opaque_tid(), bid_ = opaque_bid(); const int wid = tid_ >> 6, lane = tid_ & 63;
    const float* mod = (const float*)(p.ws + WS_MOD);
    bf16_t* P = (bf16_t*)(p.ws + WS_P);
    for (int g4 = bid_ * 8 + wid; g4 < NTOK / 4; g4 += gridDim.x * 8) {
        const int row0 = g4 * 4; const int cnd = cond_of_row(row0);
        const float* src = row0 < NCTX ? p.in[0] + (size_t)row0 * D : p.in[1] + (size_t)(row0 - NCTX) * D;
        const float* sh = mod + (0 * 5 + cnd) * 6144, *sc = sh + 1024;
        f32x4 x[4][2][2];
#pragma unroll
        for (int r = 0; r < 4; ++r)
#pragma unroll
            for (int j = 0; j < 2; ++j) { const int col = j * 512 + lane * 8; x[r][j][0] = *(const f32x4*)(src + r * D + col); x[r][j][1] = *(const f32x4*)(src + r * D + col + 4); }
#pragma unroll
        for (int j = 0; j < 2; ++j) { const int col = j * 512 + lane * 8;
            const f32x4 s0 = 1.0f + *(const f32x4*)(sc + col), s1 = 1.0f + *(const f32x4*)(sc + col + 4), b0 = *(const f32x4*)(sh + col), b1 = *(const f32x4*)(sh + col + 4);
#pragma unroll
            for (int r = 0; r < 4; ++r) store_bf16x8(P + (size_t)(row0 + r) * D + col, x[r][j][0] * s0 + b0, x[r][j][1] * s1 + b1); }
    }
}

__device__ void phase_ln(const Params& p, int layer, int which, int npart, bool wrP) {
    const int tid_ = opaque_tid(), bid_ = opaque_bid(); const int wid = tid_ >> 6, lane = tid_ & 63;
    const float* mod = (const float*)(p.ws + WS_MOD);
    const float* Z = (const float*)(p.ws + WS_Z);
    const f32x2* ST = (const f32x2*)(p.ws + WS_ST);
    float* X = p.out;
    const float* lg = p.in[8] + (layer * 2 + which) * 1024, *lb = p.in[9] + (layer * 2 + which) * 1024;
    for (int g4 = bid_ * 8 + wid; g4 < NTOK / 4; g4 += gridDim.x * 8) {
        const int row0 = g4 * 4;
        f32x2 st[4]; f32x4 z[4][2][2];
#pragma unroll
        for (int r = 0; r < 4; ++r) { st[r] = lane < npart ? ST[(size_t)(row0 + r) * 32 + lane] : (f32x2){0.f, 0.f};
#pragma unroll
            for (int j = 0; j < 2; ++j) { const size_t off = (size_t)(row0 + r) * D + j * 512 + lane * 8; z[r][j][0] = *(const f32x4*)(Z + off); z[r][j][1] = *(const f32x4*)(Z + off + 4); } }
        float mean[4], rstd[4];
#pragma unroll
        for (int r = 0; r < 4; ++r) {
#pragma unroll
            for (int o = 1; o < 64; o <<= 1) { st[r].x += __shfl_xor(st[r].x, o); st[r].y += __shfl_xor(st[r].y, o); }
            mean[r] = st[r].x * (1.0f / 1024.0f); const float var = fmaxf(st[r].y * (1.0f / 1024.0f) - mean[r] * mean[r], 0.f); rstd[r] = rsqrtf(var + LN_EPS); }
        const int cnd = cond_of_row(row0);
        const float* sh = nullptr; const float* sc = nullptr; bf16_t* dst = nullptr;
        if (which == 0) { sh = mod + (layer * 5 + cnd) * 6144 + 3 * 1024; sc = sh + 1024; dst = (bf16_t*)(p.ws + WS_Q); }
        else if (wrP) { sh = mod + ((layer + 1) * 5 + cnd) * 6144; sc = sh + 1024; dst = (bf16_t*)(p.ws + WS_P); }
#pragma unroll
        for (int j = 0; j < 2; ++j) { const int col = j * 512 + lane * 8;
            const f32x4 g0 = *(const f32x4*)(lg + col), g1 = *(const f32x4*)(lg + col + 4), b0 = *(const f32x4*)(lb + col), b1 = *(const f32x4*)(lb + col + 4);
            f32x4 s0 = {0.f, 0.f, 0.f, 0.f}, s1 = s0, h0 = s0, h1 = s0;
            if (dst) { s0 = 1.0f + *(const f32x4*)(sc + col); s1 = 1.0f + *(const f32x4*)(sc + col + 4); h0 = *(const f32x4*)(sh + col); h1 = *(const f32x4*)(sh + col + 4); }
#pragma unroll
            for (int r = 0; r < 4; ++r) { const size_t off = (size_t)(row0 + r) * D + col;
                const f32x4 x0 = (z[r][j][0] - mean[r]) * rstd[r] * g0 + b0, x1 = (z[r][j][1] - mean[r]) * rstd[r] * g1 + b1;
                *(f32x4*)(X + off) = x0; *(f32x4*)(X + off + 4) = x1;
                if (dst) store_bf16x8(dst + off, x0 * s0 + h0, x1 * s1 + h1); } }
    }
}

__device__ void phase_comb(const Params& p, int jj) {
    const int tid_ = opaque_tid(), bid_ = opaque_bid(); const int wid = tid_ >> 6, lane = tid_ & 63;
    const bf16_t* P = (const bf16_t*)(p.ws + WS_P);
    const float* YF = (const float*)(p.ws + WS_Y), *YB = YF + (size_t)NTOK * D;
    bf16_t* Q = (bf16_t*)(p.ws + WS_Q);
    const float* dsk = p.in[17] + jj * 1024;
    for (int g2 = bid_ * 8 + wid; g2 < NTOK / 2; g2 += gridDim.x * 8) {
        const int row0 = g2 * 2;
        u32x4 uw[2][2]; f32x4 yf[2][2][2], yb[2][2][2];
#pragma unroll
        for (int r = 0; r < 2; ++r)
#pragma unroll
            for (int j = 0; j < 2; ++j) { const size_t off = (size_t)(row0 + r) * D + j * 512 + lane * 8;
                uw[r][j] = *(const u32x4*)(P + off); yf[r][j][0] = *(const f32x4*)(YF + off); yf[r][j][1] = *(const f32x4*)(YF + off + 4); yb[r][j][0] = *(const f32x4*)(YB + off); yb[r][j][1] = *(const f32x4*)(YB + off + 4); }
#pragma unroll
        for (int j = 0; j < 2; ++j) { const int col = j * 512 + lane * 8; const f32x4 d0 = *(const f32x4*)(dsk + col), d1 = *(const f32x4*)(dsk + col + 4);
#pragma unroll
            for (int r = 0; r < 2; ++r) { const u32x4 w = uw[r][j];
                const f32x4 u0 = {bf_lo(w.x), bf_hi(w.x), bf_lo(w.y), bf_hi(w.y)}, u1 = {bf_lo(w.z), bf_hi(w.z), bf_lo(w.w), bf_hi(w.w)};
                f32x4 y0 = u0 * d0 + yf[r][j][0] + yb[r][j][0], y1 = u1 * d1 + yf[r][j][1] + yb[r][j][1];
#pragma unroll
                for (int e = 0; e < 4; ++e) { y0[e] = gelu_tanh(y0[e]); y1[e] = gelu_tanh(y1[e]); }
                store_bf16x8(Q + (size_t)(row0 + r) * D + col, y0, y1); } }
    }
}

template <int K> __device__ __forceinline__ void pool2d_task(const float* X, const float* mod, bf16_t* Q, int layer, int b, int c, int ch) {
    const int clo = max(c - K / 2, 0), chi = min(c - K / 2 + K, 64);
    const size_t tb = (size_t)(NCTX + b * 2048);
    f32x2 hs[32];
#pragma unroll
    for (int r = 0; r < 32; ++r) hs[r] = (f32x2){0.f, 0.f};
    for (int cc = clo; cc < chi; ++cc) {
        const float* xp = X + (tb + cc) * D + ch;
#pragma unroll
        for (int rh = 0; rh < 2; ++rh) {
            f32x2 t_[16];
#pragma unroll
            for (int r = 0; r < 16; ++r) t_[r] = *(const f32x2*)(xp + (size_t)(rh * 16 + r) * 64 * D);
#pragma unroll
            for (int r = 0; r < 16; ++r) hs[rh * 16 + r] += t_[r]; } }
    const f32x2 sc = *(const f32x2*)(mod + (layer * 5 + 1 + b) * 6144 + 1024 + ch);
#pragma unroll
    for (int r = 0; r < 32; ++r) { const int rlo = (r - K / 2) < 0 ? 0 : (r - K / 2), rhi = (r - K / 2 + K) > 32 ? 32 : (r - K / 2 + K);
        f32x2 t = {0.f, 0.f};
#pragma unroll
        for (int rr = rlo; rr < rhi; ++rr) t += hs[rr];
        const float inv = 1.0f / (float)((rhi - rlo) * (chi - clo));
        const size_t off = (tb + r * 64 + c) * D + ch;
        const f32x2 xc = *(const f32x2*)(X + off);
        const f32x2 o = (t * inv - xc) * (1.0f + sc);
        *(unsigned*)(Q + off) = cvt_pk_bf16(o.x, o.y); }
}
template <int K> __device__ __forceinline__ void pool1d_task(const float* X, const float* mod, bf16_t* Q, int layer, int b, int t0, int ch) {
    const size_t tb = (size_t)b * 256;
    f32x2 v[16 + K];
#pragma unroll
    for (int i = 0; i < 16 + K; ++i) { const int t = t0 - K / 2 + i; v[i] = (t >= 0 && t < 256) ? *(const f32x2*)(X + (tb + t) * D + ch) : (f32x2){0.f, 0.f}; }
    const f32x2 sc = *(const f32x2*)(mod + (layer * 5 + 0) * 6144 + 1024 + ch);
#pragma unroll
    for (int i = 0; i < 16; ++i) { const int t = t0 + i; const int lo = max(t - K / 2, 0), hi = min(t - K / 2 + K, 256);
        f32x2 s = {0.f, 0.f};
#pragma unroll
        for (int k2 = 0; k2 < K; ++k2) s += v[i + k2];
        const float inv = 1.0f / (float)(hi - lo);
        const f32x2 o = (s * inv - v[i + K / 2]) * (1.0f + sc);
        *(unsigned*)(Q + (tb + t) * D + ch) = cvt_pk_bf16(o.x, o.y); }
}
__device__ void phase_poolprep(const Params& p, int layer) {
    const int tid_ = opaque_tid(), bid_ = opaque_bid(); const int wid = tid_ >> 6, lane = tid_ & 63;
    const float* X = p.out; const float* mod = (const float*)(p.ws + WS_MOD); bf16_t* Q = (bf16_t*)(p.ws + WS_Q);
    const int nslots = gridDim.x * 8;
    for (int t = wid * gridDim.x + bid_; t < 2048 + 4096; t += nslots) {
        if (t < 2048) { const int gi = 3 - (t >> 9), r = t & 511, b = r >> 7, c = (r >> 1) & 63, half = r & 1; const int ch = gi * 256 + half * 128 + lane * 2;
            if (gi == 3) pool2d_task<16>(X, mod, Q, layer, b, c, ch); else if (gi == 2) pool2d_task<8>(X, mod, Q, layer, b, c, ch);
            else if (gi == 1) pool2d_task<4>(X, mod, Q, layer, b, c, ch); else pool2d_task<2>(X, mod, Q, layer, b, c, ch);
        } else { const int u = t - 2048; const int gi = 3 - (u >> 10), r = u & 1023, b = r >> 5, seg = (r >> 1) & 15, half = r & 1; const int ch = gi * 256 + half * 128 + lane * 2;
            if (gi == 3) pool1d_task<16>(X, mod, Q, layer, b, seg * 16, ch); else if (gi == 2) pool1d_task<8>(X, mod, Q, layer, b, seg * 16, ch);
            else if (gi == 1) pool1d_task<4>(X, mod, Q, layer, b, seg * 16, ch); else pool1d_task<2>(X, mod, Q, layer, b, seg * 16, ch);
        }
    }
}

constexpr int S5_ROWB = 272;
constexpr int S5_WAVE_LDS = 32 * S5_ROWB;

template <int MODE>
__device__ void s5_task(const Params& p, int jj, int task, LAS unsigned char* wl, int lane) {
    const int pair = task >> 7, dir = (task >> 6) & 1, g = task & 63;
    constexpr int L = 256, ntile = 16;
    const int half = lane >> 5, p0 = lane & 31;
    const int pidx = (jj * 2 + dir) * 64 + g;
    const float dt = expf(p.in[12][pidx]);
    float ar[2], ai[2]; bf16x8 Bre[2], Bim[2];
#pragma unroll
    for (int s = 0; s < 2; ++s) { const int P = p0 + 32 * s;
        const float are = p.in[10][pidx * 64 + P], aim = p.in[11][pidx * 64 + P];
        const float mag = expf(are * dt), ang = aim * dt; float sn, cs; sn = sinf(ang); cs = cosf(ang);
        const float abr = mag * cs, abi = mag * sn, den = are * are + aim * aim, nr = abr - 1.0f;
        const float cr = (nr * are + abi * aim) / den, ci = (abi * are - nr * aim) / den;
        const float* br = p.in[13] + ((size_t)(pidx * 64 + P) * 16 + half * 8), *bi = p.in[14] + ((size_t)(pidx * 64 + P) * 16 + half * 8);
        const f32x4 br0 = *(const f32x4*)br, br1 = *(const f32x4*)(br + 4), bi0 = *(const f32x4*)bi, bi1 = *(const f32x4*)(bi + 4);
        const f32x4 r0 = cr * br0 - ci * bi0, r1 = cr * br1 - ci * bi1, i0 = cr * bi0 + ci * br0, i1 = cr * bi1 + ci * br1;
        u32x4 wr_, wi_;
        wr_.x = cvt_pk_bf16(r0[0], r0[1]); wr_.y = cvt_pk_bf16(r0[2], r0[3]); wr_.z = cvt_pk_bf16(r1[0], r1[1]); wr_.w = cvt_pk_bf16(r1[2], r1[3]);
        wi_.x = cvt_pk_bf16(i0[0], i0[1]); wi_.y = cvt_pk_bf16(i0[2], i0[3]); wi_.z = cvt_pk_bf16(i1[0], i1[1]); wi_.w = cvt_pk_bf16(i1[2], i1[3]);
        Bre[s] = __builtin_bit_cast(bf16x8, wr_); Bim[s] = __builtin_bit_cast(bf16x8, wi_);
        ar[s] = abr; ai[s] = abi; }
    const int csc = pair * 2 + half;
    f32x2* E = (f32x2*)(p.ws + WS_E);
    float sr[2], si[2];
#pragma unroll
    for (int s = 0; s < 2; ++s) { sr[s] = 0.f; si[s] = 0.f; }
    if (MODE == 2) {
        const int b = csc >> 3, k = csc & 7;
#pragma unroll
        for (int s = 0; s < 2; ++s) { const int P = p0 + 32 * s;
            float qr = ar[s], qi = ai[s];
#pragma unroll
            for (int e = 0; e < 8; ++e) { const float t = qr * qr - qi * qi; qi = 2.0f * qr * qi; qr = t; }
            const size_t ix = ((size_t)((b * 2 + jj) * 2 + dir) * 64 + g) * 64 + P;
            float hr = p.in[2][ix], hi = p.in[3][ix];
            for (int e = 0; e < 7; ++e) { const int kk = dir ? 7 - e : e;
                const bool pre = dir ? (kk > k) : (kk < k);
                const f32x2 ev = E[((size_t)((b * 8 + kk) * 2 + dir) * 64 + g) * 64 + P];
                if (pre) { const float t = qr * hr - qi * hi + ev.x; hi = qr * hi + qi * hr + ev.y; hr = t; } }
            sr[s] = hr; si[s] = hi; }
    }
    bf16x8 Cop[4];
    if (MODE != 1) { const int n = lane & 15, kq = lane >> 4;
#pragma unroll
      for (int ks = 0; ks < 4; ++ks) { const int pp = ks * 16 + kq * 4;
          const f32x4 cre = *(const f32x4*)(p.in[15] + ((size_t)(pidx * 16 + n) * 64 + pp)), cim = *(const f32x4*)(p.in[16] + ((size_t)(pidx * 16 + n) * 64 + pp));
          u32x4 w; w.x = cvt_pk_bf16(cre[0], -cim[0]); w.y = cvt_pk_bf16(cre[1], -cim[1]); w.z = cvt_pk_bf16(cre[2], -cim[2]); w.w = cvt_pk_bf16(cre[3], -cim[3]);
          Cop[ks] = __builtin_bit_cast(bf16x8, w); } }
    const int m = lane & 31, lc = (m >> 2) & 1, ltau = ((m >> 3) << 2) | (m & 3), kh = lane >> 5;
    const int lch = pair * 2 + lc; const int lbase = MODE == 0 ? lch * 256 : NCTX + lch * 256;
    const bf16_t* Pu = (const bf16_t*)(p.ws + WS_P) + g * 16 + kh * 8;
    float* Yd = (float*)(p.ws + WS_Y) + (size_t)dir * NTOK * D + g * 16 + (lane >> 4) * 4;
    const int otau = lane & 15;
    auto tok_of = [&](int base, int ti, int tau) { const int step = ti * 16 + tau; return base + (dir ? (L - 1 - step) : step); };
    bf16x8 u0 = *(const bf16x8*)(Pu + (size_t)tok_of(lbase, 0, ltau) * D);
    bf16x8 u1 = *(const bf16x8*)(Pu + (size_t)tok_of(lbase, 1, ltau) * D);
    const f32x16 zero16 = {0.f, 0.f, 0.f, 0.f, 0.f, 0.f, 0.f, 0.f, 0.f, 0.f, 0.f, 0.f, 0.f, 0.f, 0.f, 0.f};
    for (int ti = 0; ti < ntile; ++ti) {
        const int tn = min(ti + 2, ntile - 1);
        const bf16x8 u2 = *(const bf16x8*)(Pu + (size_t)tok_of(lbase, tn, ltau) * D);
        f32x16 dre[2], dim_[2];
#pragma unroll
        for (int s = 0; s < 2; ++s) { dre[s] = __builtin_amdgcn_mfma_f32_32x32x16_bf16(u0, Bre[s], zero16, 0, 0, 0); dim_[s] = __builtin_amdgcn_mfma_f32_32x32x16_bf16(u0, Bim[s], zero16, 0, 0, 0); }
        float x0r = sr[0], x0i = si[0], x1r = sr[1], x1i = si[1];
#pragma unroll
        for (int i = 0; i < 16; ++i) {
            const float n0r = fmaf(ar[0], x0r, fmaf(-ai[0], x0i, dre[0][i])), n0i = fmaf(ar[0], x0i, fmaf(ai[0], x0r, dim_[0][i]));
            const float n1r = fmaf(ar[1], x1r, fmaf(-ai[1], x1i, dre[1][i])), n1i = fmaf(ar[1], x1i, fmaf(ai[1], x1r, dim_[1][i]));
            x0r = n0r; x0i = n0i; x1r = n1r; x1i = n1i;
            if (MODE != 1) { *(LAS unsigned*)(wl + (half * 16 + i) * S5_ROWB + p0 * 4) = cvt_pk_bf16(x0r, x0i);
                             *(LAS unsigned*)(wl + (half * 16 + i) * S5_ROWB + (p0 + 32) * 4) = cvt_pk_bf16(x1r, x1i); }
        }
        sr[0] = x0r; si[0] = x0i; sr[1] = x1r; si[1] = x1i;
        if (MODE != 1) {
            asm volatile("s_waitcnt lgkmcnt(0)" ::: "memory");
            __builtin_amdgcn_wave_barrier();
#pragma unroll
            for (int c = 0; c < 2; ++c) { f32x4 acc = {0.f, 0.f, 0.f, 0.f};
#pragma unroll
                for (int ks = 0; ks < 4; ++ks) { const bf16x8 sf = *(const LAS bf16x8*)(wl + (c * 16 + otau) * S5_ROWB + ks * 64 + (lane >> 4) * 16);
                    acc = __builtin_amdgcn_mfma_f32_16x16x32_bf16(Cop[ks], sf, acc, 0, 0, 0); }
                const int och = pair * 2 + c; const int obase = MODE == 0 ? och * 256 : NCTX + och * 256;
                *(f32x4*)(Yd + (size_t)tok_of(obase, ti, otau) * D) = acc; }
            asm volatile("s_waitcnt lgkmcnt(0)" ::: "memory");
            __builtin_amdgcn_wave_barrier();
        }
        u0 = u1; u1 = u2;
    }
    if (MODE == 0) { float* ore = p.out + (size_t)NTOK * D, *oim = ore + 32 * 2 * 2 * 64 * 64;
#pragma unroll
        for (int s = 0; s < 2; ++s) { const size_t ix = ((size_t)((csc * 2 + jj) * 2 + dir) * 64 + g) * 64 + p0 + 32 * s; ore[ix] = sr[s]; oim[ix] = si[s]; } }
    if (MODE == 1) {
#pragma unroll
        for (int s = 0; s < 2; ++s) E[((size_t)(csc * 2 + dir) * 64 + g) * 64 + p0 + 32 * s] = (f32x2){sr[s], si[s]}; }
}

__device__ void phase_s5(const Params& p, int jj, int sub, LAS unsigned char* lds) {
    const int tid_ = opaque_tid(), bid_ = opaque_bid(); const int wid = tid_ >> 6, lane = tid_ & 63;
    const int G = gridDim.x, nslots = G * 8, slot = wid * G + bid_;
    LAS unsigned char* wl = lds + wid * S5_WAVE_LDS;
    if (sub == 0) { for (int t = slot; t < 4096; t += nslots) { if (t < 2048) s5_task<1>(p, jj, t, wl, lane); else s5_task<0>(p, jj, t - 2048, wl, lane); } }
    else { for (int t = slot; t < 2048; t += nslots) s5_task<2>(p, jj, t, wl, lane); }
}

namespace pg8 {
constexpr int BM = 256, BK = 64, HALF = 128, HTB = HALF * BK * 2, NXCD = 8, WGM = 8;
__device__ __forceinline__ int lds_byte(int r, int c) { const int st = (r >> 4) * 2 + (c >> 5), rr = r & 15, cc = c & 31, ob = rr * 64 + cc * 2; return st * 1024 + (ob ^ (((ob >> 9) & 1) << 5)); }
__device__ __forceinline__ void stage_rc(int b, int& R, int& C) { const int st = b / 1024, sb = b % 1024, swz = sb ^ (((sb >> 9) & 1) << 5); R = (st >> 1) * 16 + swz / 64; C = (st & 1) * 32 + (swz % 64) / 2; }
struct Unit { int pm, pn; };
struct Gemm { const bf16_t* A; const bf16_t* Bt; int M, N, K, lda, acol; };
struct StaticOrder {
    int nM, nN, nwg, G, c;
    __device__ void init(int M, int N, int G_, int c_) { nM = M / BM; nN = N / BM; nwg = nM * nN; G = G_; c = c_; }
    __device__ bool next(int i, Unit& u) const {
        const long L = (long)i * G + c; if (L >= nwg) return false;
        int wgid = (int)L; { const int q = nwg / NXCD, r = nwg % NXCD, xcd = wgid % NXCD, off = wgid / NXCD; wgid = (xcd < r ? xcd * (q + 1) : r * (q + 1) + (xcd - r) * q) + off; }
        const int nig = WGM * nN, gid = wgid / nig, fm = gid * WGM, gsz = (nM - fm) < WGM ? (nM - fm) : WGM;
        u.pm = fm + ((wgid % nig) % gsz); u.pn = (wgid % nig) / gsz; return true;
    }
};

template <class Epi>
__device__ __forceinline__ void gemm_phase(LAS unsigned char* lds, const Gemm g, const StaticOrder& S, const Epi& E) {
    const int tid = opaque_tid(), wid = __builtin_amdgcn_readfirstlane(tid >> 6), lane = tid & 63, wr = wid >> 2, wc = wid & 3, fr = lane & 15, fq = lane >> 4;
    const int K = g.K, nt = K / BK, lda = g.lda;
    unsigned voffA[2], voffB[2];
#pragma unroll
    for (int i = 0; i < 2; ++i) { int R, C; stage_rc(tid * 16 + i * 8192, R, C); voffA[i] = (unsigned)(R * lda + C) * 2u; voffB[i] = (unsigned)(R * K + C) * 2u; }
    const size_t kstep = (size_t)(BK * 2);
    const size_t hstepA = (size_t)HALF * lda * 2, hstepB = (size_t)HALF * K * 2;
    const size_t tstepA = 2 * hstepA, tstepB = 2 * hstepB;
    const size_t acolb = (size_t)g.acol * 2;
    const unsigned ldsw = (unsigned)wid * 1024u;
    const int aoff = lds_byte(wr * 64 + fr, fq * 8), boff = lds_byte(wc * 32 + fr, fq * 8);
#define PG8_SA(b, h) (((b) * 2 + (h)) * HTB)
#define PG8_SB(b, h) ((4 + (b) * 2 + (h)) * HTB)
#define PG8_STAGE(bufoff, gbase, voff) do { _Pragma("unroll") for (int _i = 0; _i < 2; ++_i) \
        __builtin_amdgcn_global_load_lds((const unsigned*)((const char*)(gbase) + (voff)[_i]), (LAS unsigned*)(lds + (bufoff) + ldsw + _i * 8192), 16, 0, 0); } while (0)
#define PG8_LDA(dst, b, h) do { _Pragma("unroll") for (int m = 0; m < 4; ++m) _Pragma("unroll") for (int k = 0; k < 2; ++k) dst[m][k] = *(const LAS bf16x8*)(lds + PG8_SA(b, h) + aoff + m * 2048 + k * 1024); } while (0)
#define PG8_LDB(dst, b, h) do { _Pragma("unroll") for (int n = 0; n < 2; ++n) _Pragma("unroll") for (int k = 0; k < 2; ++k) dst[n][k] = *(const LAS bf16x8*)(lds + PG8_SB(b, h) + boff + n * 2048 + k * 1024); } while (0)
#define PG8_MMA(ai, bj, At, Bt) do { __builtin_amdgcn_s_setprio(1); _Pragma("unroll") for (int m = 0; m < 4; ++m) _Pragma("unroll") for (int n = 0; n < 2; ++n) _Pragma("unroll") for (int k = 0; k < 2; ++k) \
        acc[ai][bj][m][n] = __builtin_amdgcn_mfma_f32_16x16x32_bf16(Bt[n][k], At[m][k], acc[ai][bj][m][n], 0, 0, 0); __builtin_amdgcn_s_setprio(0); } while (0)
#define PG8_WAIT_V(n) asm volatile("s_waitcnt vmcnt(" #n ")" ::: "memory")
#define PG8_WAIT_L(n) asm volatile("s_waitcnt lgkmcnt(" #n ")" ::: "memory")
#define PG8_BAR __builtin_amdgcn_s_barrier()
#define PG8_SCHED __builtin_amdgcn_sched_barrier(0)
    Unit cur, nxt; int ui = 0;
    if (!S.next(0, cur)) return;
    f32x4 acc[2][2][4][2];
#pragma unroll
    for (int a = 0; a < 2; ++a)
#pragma unroll
        for (int b = 0; b < 2; ++b)
#pragma unroll
            for (int m = 0; m < 4; ++m)
#pragma unroll
                for (int n = 0; n < 2; ++n) acc[a][b][m][n] = (f32x4){0.f, 0.f, 0.f, 0.f};
    bf16x8 At[4][2], B0[2][2], B1[2][2];
    const char* cA = (const char*)g.A + (size_t)cur.pm * tstepA + (size_t)cur.pn * acolb; const char* cB = (const char*)g.Bt + (size_t)cur.pn * tstepB;
    PG8_STAGE(PG8_SB(0, 0), cB, voffB); PG8_STAGE(PG8_SA(0, 0), cA, voffA); PG8_STAGE(PG8_SB(0, 1), cB + hstepB, voffB); PG8_STAGE(PG8_SA(0, 1), cA + hstepA, voffA);
    if (wr == 1) PG8_BAR;
    PG8_WAIT_V(4); PG8_BAR;
    PG8_STAGE(PG8_SB(1, 0), cB + kstep, voffB); PG8_STAGE(PG8_SA(1, 0), cA + kstep, voffA); PG8_STAGE(PG8_SB(1, 1), cB + hstepB + kstep, voffB);
    PG8_WAIT_V(6); PG8_BAR;
    for (;;) {
        const bool has_next = S.next(ui + 1, nxt);
        const char* nA = has_next ? (const char*)g.A + (size_t)nxt.pm * tstepA + (size_t)nxt.pn * acolb : cA; const char* nB = has_next ? (const char*)g.Bt + (size_t)nxt.pn * tstepB : cB;
        for (int t = 0; t < nt; t += 2) {
            const bool last = (t == nt - 2);
            const char* a1 = cA + (size_t)(t + 1) * kstep;
            const char* a2 = last ? nA : cA + (size_t)(t + 2) * kstep; const char* b2 = last ? nB : cB + (size_t)(t + 2) * kstep;
            const char* a3 = a2 + kstep; const char* b3 = b2 + kstep;
            PG8_LDB(B0, 0, 0); PG8_SCHED; PG8_LDA(At, 0, 0); PG8_STAGE(PG8_SA(1, 1), a1 + hstepA, voffA);
            PG8_WAIT_L(8); PG8_BAR; PG8_WAIT_L(0); PG8_MMA(0, 0, At, B0); PG8_BAR; PG8_SCHED;
            PG8_LDB(B1, 0, 1); PG8_STAGE(PG8_SB(0, 0), b2, voffB);
            PG8_BAR; PG8_WAIT_L(0); PG8_MMA(0, 1, At, B1); PG8_BAR;
            PG8_LDA(At, 0, 1); PG8_STAGE(PG8_SA(0, 0), a2, voffA);
            PG8_BAR; PG8_WAIT_L(0); PG8_MMA(1, 0, At, B0); PG8_BAR; PG8_SCHED;
            PG8_STAGE(PG8_SB(0, 1), b2 + hstepB, voffB);
            PG8_WAIT_V(6); PG8_BAR; PG8_MMA(1, 1, At, B1); PG8_BAR;
            PG8_LDB(B0, 1, 0); PG8_SCHED; PG8_LDA(At, 1, 0); PG8_STAGE(PG8_SA(0, 1), a2 + hstepA, voffA);
            PG8_WAIT_L(8); PG8_BAR; PG8_WAIT_L(0); PG8_MMA(0, 0, At, B0); PG8_BAR; PG8_SCHED;
            PG8_LDB(B1, 1, 1); PG8_STAGE(PG8_SB(1, 0), b3, voffB);
            PG8_BAR; PG8_WAIT_L(0); PG8_MMA(0, 1, At, B1); PG8_BAR;
            PG8_LDA(At, 1, 1); PG8_STAGE(PG8_SA(1, 0), a3, voffA);
            PG8_BAR; PG8_WAIT_L(0); PG8_MMA(1, 0, At, B0); PG8_BAR; PG8_SCHED;
            PG8_STAGE(PG8_SB(1, 1), b3 + hstepB, voffB);
            PG8_WAIT_V(6); PG8_BAR; PG8_MMA(1, 1, At, B1); PG8_BAR;
        }
        E(acc, cur, wr, wc, fr, fq);
        if (!has_next) break;
#pragma unroll
        for (int a = 0; a < 2; ++a)
#pragma unroll
            for (int b = 0; b < 2; ++b)
#pragma unroll
                for (int m = 0; m < 4; ++m)
#pragma unroll
                    for (int n = 0; n < 2; ++n) acc[a][b][m][n] = (f32x4){0.f, 0.f, 0.f, 0.f};
        cur = nxt; cA = nA; cB = nB; ++ui;
    }
    PG8_WAIT_V(0);
    if (wr == 0) PG8_BAR;
    PG8_BAR;
#undef PG8_SA
#undef PG8_SB
#undef PG8_STAGE
#undef PG8_LDA
#undef PG8_LDB
#undef PG8_MMA
#undef PG8_WAIT_V
#undef PG8_WAIT_L
#undef PG8_BAR
#undef PG8_SCHED
}
}

__device__ __forceinline__ void stat_store(float s, float q, f32x2* ST, int row, int part, int fq) {
    s += __shfl_xor(s, 16); s += __shfl_xor(s, 32); q += __shfl_xor(q, 16); q += __shfl_xor(q, 32);
    if (fq == 0) ST[(size_t)row * 32 + part] = (f32x2){s, q};
}
struct EpiGlu {
    const float* bias; const float* xlo; const float* xhi; const float* mod; float* Z; f32x2* ST;
    __device__ __forceinline__ void operator()(const f32x4 (&acc)[2][2][4][2], const pg8::Unit& u, int wr, int wc, int fr, int fq) const {
        const int cnd = u.pm < 32 ? 0 : 1 + ((u.pm - 32) >> 3);
        const float* xb = u.pm < 32 ? xlo : xhi; const float* g1 = mod + cnd * 6144 + 2 * 1024;
        int oc[2]; f32x4 bv[2], bg[2], gv[2];
#pragma unroll
        for (int bj = 0; bj < 2; ++bj) { oc[bj] = (u.pn * 8 + bj * 4 + wc) * 16 + 4 * fq; bv[bj] = *(const f32x4*)(bias + oc[bj]); bg[bj] = *(const f32x4*)(bias + 1024 + oc[bj]); gv[bj] = *(const f32x4*)(g1 + oc[bj]); }
#pragma unroll
        for (int ai = 0; ai < 2; ++ai) {
            f32x4 xr[4][2];
#pragma unroll
            for (int m = 0; m < 4; ++m)
#pragma unroll
                for (int bj = 0; bj < 2; ++bj) xr[m][bj] = *(const f32x4*)(xb + (size_t)(u.pm * 256 + ai * 128 + wr * 64 + m * 16 + fr) * D + oc[bj]);
#pragma unroll
            for (int m = 0; m < 4; ++m) { const int row = u.pm * 256 + ai * 128 + wr * 64 + m * 16 + fr; float s = 0.f, q = 0.f;
#pragma unroll
                for (int bj = 0; bj < 2; ++bj) { const f32x4 v = acc[ai][bj][m][0] + bv[bj], gt = acc[ai][bj][m][1] + bg[bj]; f32x4 o;
#pragma unroll
                    for (int e = 0; e < 4; ++e) o[e] = v[e] * sigmoidf_(gt[e]);
                    const f32x4 z = ALPHA * xr[m][bj] + gv[bj] * o;
                    *(f32x4*)(Z + (size_t)row * D + oc[bj]) = z; s += (z[0] + z[1]) + (z[2] + z[3]); q += (z[0] * z[0] + z[1] * z[1]) + (z[2] * z[2] + z[3] * z[3]); }
                stat_store(s, q, ST, row, u.pn * 4 + wc, fq); }
            asm volatile("" ::: "memory"); }
    }
};
struct EpiFfn1 {
    bf16_t* H;
    __device__ __forceinline__ void operator()(const f32x4 (&acc)[2][2][4][2], const pg8::Unit& u, int wr, int wc, int fr, int fq) const {
#pragma unroll
        for (int ai = 0; ai < 2; ++ai)
#pragma unroll
            for (int m = 0; m < 4; ++m) { const int row = u.pm * 256 + ai * 128 + wr * 64 + m * 16 + fr;
#pragma unroll
                for (int bj = 0; bj < 2; ++bj) { const int oc = (u.pn * 8 + bj * 4 + wc) * 16 + 4 * fq; const f32x4 gt = acc[ai][bj][m][0], up = acc[ai][bj][m][1]; f32x4 h;
#pragma unroll
                    for (int e = 0; e < 4; ++e) h[e] = gt[e] * sigmoidf_(gt[e]) * up[e];
                    u32x2 w; w.x = cvt_pk_bf16(h[0], h[1]); w.y = cvt_pk_bf16(h[2], h[3]); *(u32x2*)(H + (size_t)row * DFF + oc) = w; } }
    }
};
struct EpiRes {
    const float* X; const float* mod; int gchunk; const float* scale; float* Z; f32x2* ST;
    __device__ __forceinline__ void operator()(const f32x4 (&acc)[2][2][4][2], const pg8::Unit& u, int wr, int wc, int fr, int fq) const {
        const int cnd = u.pm < 32 ? 0 : 1 + ((u.pm - 32) >> 3);
        const float* gp = mod + cnd * 6144 + gchunk * 1024;
        const int col0 = u.pn * 256 + wc * 32 + 4 * fq;
        f32x4 gv[2][2];
#pragma unroll
        for (int bj = 0; bj < 2; ++bj)
#pragma unroll
            for (int n = 0; n < 2; ++n) { const int col = col0 + bj * 128 + n * 16; gv[bj][n] = *(const f32x4*)(gp + col); if (scale) gv[bj][n] *= *(const f32x4*)(scale + col); }
#pragma unroll
        for (int ai = 0; ai < 2; ++ai)
#pragma unroll
            for (int mh = 0; mh < 2; ++mh) {
                f32x4 xr[2][2][2];
#pragma unroll
                for (int m2 = 0; m2 < 2; ++m2)
#pragma unroll
                    for (int bj = 0; bj < 2; ++bj)
#pragma unroll
                        for (int n = 0; n < 2; ++n) xr[m2][bj][n] = *(const f32x4*)(X + (size_t)(u.pm * 256 + ai * 128 + wr * 64 + (mh * 2 + m2) * 16 + fr) * D + col0 + bj * 128 + n * 16);
#pragma unroll
                for (int m2 = 0; m2 < 2; ++m2) { const int m = mh * 2 + m2; const int row = u.pm * 256 + ai * 128 + wr * 64 + m * 16 + fr; float s = 0.f, q = 0.f;
#pragma unroll
                    for (int bj = 0; bj < 2; ++bj)
#pragma unroll
                        for (int n = 0; n < 2; ++n) { const int col = col0 + bj * 128 + n * 16;
                            const f32x4 z = ALPHA * xr[m2][bj][n] + gv[bj][n] * acc[ai][bj][m][n];
                            *(f32x4*)(Z + (size_t)row * D + col) = z; s += (z[0] + z[1]) + (z[2] + z[3]); q += (z[0] * z[0] + z[1] * z[1]) + (z[2] * z[2] + z[3] * z[3]); }
                    stat_store(s, q, ST, row, u.pn * 4 + wc, fq); }
                asm volatile("" ::: "memory"); }
    }
};

__device__ __forceinline__ void first_seam(const Params& p, LAS unsigned char* lds) {
    volatile LAS unsigned* xst = (volatile LAS unsigned*)(lds + LDS_ST_OFF);
    if (threadIdx.x == 0) { xst[0] = 0u; xst[1] = 0u; }
    __syncthreads();
    (void)xcd_barrier_post((unsigned*)(p.ws + WS_BAR), xst);
}
__device__ __forceinline__ void later_seam(const Params& p, LAS unsigned char* lds) {
    XcdBarrier xb; xb.bar = (unsigned*)(p.ws + WS_BAR); xb.x = xb_xcc_id(); xb.st = (volatile LAS unsigned*)(lds + LDS_ST_OFF);
    xcd_barrier(xb);
}

__global__ void __launch_bounds__(512) mega(Params p) {
    extern __shared__ __attribute__((aligned(16))) unsigned char lds_raw[];
    LAS unsigned char* lds = (LAS unsigned char*)lds_raw;
    cg::grid_group grid = cg::this_grid();
    int ph = 0;
    if (blockIdx.x == 0) for (int i = threadIdx.x; i < XCD_BAR_WORDS; i += 512) ((unsigned*)(p.ws + WS_BAR))[i] = 0u;
#define PHASE_LOCALS const float* mod = (const float*)(p.ws + WS_MOD); float* Z = (float*)(p.ws + WS_Z); f32x2* ST = (f32x2*)(p.ws + WS_ST); bf16_t* Q = (bf16_t*)(p.ws + WS_Q); bf16_t* Hff = (bf16_t*)(p.ws + WS_Y); pg8::StaticOrder S; const float* lmod = mod + layer * 5 * 6144; (void)Z; (void)ST; (void)Q; (void)Hff; (void)lmod; (void)S
#define PHASE(kind, ...) do { if (ph >= p.ph_lo && ph < p.ph_hi) { for (int r_ = 0; r_ <= ((REPMASK >> (kind)) & 1); ++r_) { { const Params& pp_ = p; { Params p = pp_; asm volatile("" : "+s"(p.ws), "+s"(p.out)); PHASE_LOCALS; __VA_ARGS__; } } if (ph + 1 < p.ph_hi || r_ < ((REPMASK >> (kind)) & 1)) { if (ph == p.ph_lo && r_ == 0) { grid.sync(); first_seam(p, lds); } else later_seam(p, lds); } } } ++ph; } while (0)
    { const int layer = 0; (void)layer;
    PHASE(0, phase_w0(p, lds));
    PHASE(1, phase_prep0(p)); }
    for (int layer_ = 0; layer_ < 4; ++layer_) {
        const int layer = opaque_s(layer_);
        const int jj = layer >> 1;
        if ((layer & 1) == 0) {
            PHASE(2, phase_s5(p, jj, 0, lds));
            PHASE(2, phase_s5(p, jj, 1, lds));
            PHASE(3, phase_comb(p, jj));
            PHASE(4, { pg8::Gemm g{Q, (const bf16_t*)(p.ws + WS_WG) + (size_t)jj * 2048 * 1024, NTOK, 2048, 1024, 1024, 0}; S.init(NTOK, 2048, gridDim.x, opaque_bid());
                    EpiGlu E{p.in[19] + jj * 2048, layer == 0 ? p.in[0] : p.out, layer == 0 ? p.in[1] - (size_t)NCTX * D : p.out, lmod, Z, ST};
                    pg8::gemm_phase(lds, g, S, E); });
            PHASE(5, phase_ln(p, layer, 0, 32, false));
        } else {
            PHASE(6, phase_poolprep(p, layer));
            PHASE(7, { pg8::Gemm g{Q, (const bf16_t*)(p.ws + WS_WP) + (size_t)jj * 4 * 65536, NTOK, 1024, 256, 1024, 256}; S.init(NTOK, 1024, gridDim.x, opaque_bid());
                    EpiRes E{p.out, lmod, 2, p.in[21] + jj * 1024, Z, ST};
                    pg8::gemm_phase(lds, g, S, E); });
            PHASE(5, phase_ln(p, layer, 0, 16, false));
        }
        PHASE(8, { pg8::Gemm g{Q, (const bf16_t*)(p.ws + WS_W1) + (size_t)layer * NFF1 * 1024, NTOK, NFF1, 1024, 1024, 0}; S.init(NTOK, NFF1, gridDim.x, opaque_bid());
                EpiFfn1 E{Hff}; pg8::gemm_phase(lds, g, S, E); });
        PHASE(9, { pg8::Gemm g{Hff, (const bf16_t*)(p.ws + WS_W2) + (size_t)layer * 1024 * DFF, NTOK, 1024, DFF, DFF, 0}; S.init(NTOK, 1024, gridDim.x, opaque_bid());
                EpiRes E{p.out, lmod, 5, nullptr, Z, ST}; pg8::gemm_phase(lds, g, S, E); });
        PHASE(10, phase_ln(p, layer, 1, 16, layer == 1));
    }
#undef PHASE
}

extern "C" void kernel_launch(void* const* d_in, const int* in_sizes, int n_in, void* d_out, int out_size, void* d_ws, size_t ws_size, hipStream_t stream) {
    static int grid_blocks = 0;
    if (grid_blocks == 0) {
        if (n_in != 25 || ws_size < WS_END) { fprintf(stderr, "kernel_launch: unexpected n_in %d or ws_size %zu (< %zu)\n", n_in, ws_size, (size_t)WS_END); grid_blocks = -1; return; }
        int dev = 0, cus = 0, per_cu = 0;
        hipGetDevice(&dev);
        hipDeviceGetAttribute(&cus, hipDeviceAttributeMultiprocessorCount, dev);
        if (hipFuncSetAttribute((const void*)mega, hipFuncAttributeMaxDynamicSharedMemorySize, LDS_BYTES) != hipSuccess) { fprintf(stderr, "kernel_launch: hipFuncSetAttribute failed\n"); grid_blocks = -1; return; }
        if (hipOccupancyMaxActiveBlocksPerMultiprocessor(&per_cu, (const void*)mega, 512, LDS_BYTES) != hipSuccess || per_cu < 1) { fprintf(stderr, "kernel_launch: occupancy query failed (%d)\n", per_cu); (void)hipGetLastError(); per_cu = 1; }
        if (per_cu > 1) per_cu = 1;
        grid_blocks = cus * per_cu;
    }
    if (grid_blocks < 0) return;
    Params p{};
    for (int i = 0; i < 25; ++i) p.in[i] = (const float*)d_in[i];
    p.out = (float*)d_out; p.ws = (unsigned char*)d_ws;
#if MULTI_LAUNCH
    for (int ph = 0; ph < NPH; ++ph) { p.ph_lo = ph; p.ph_hi = ph + 1; hipLaunchKernelGGL(mega, dim3(grid_blocks), dim3(512), LDS_BYTES, stream, p); }
#else
    p.ph_lo = 0; p.ph_hi = NPH;
    void* args[] = {&p};
    hipError_t e = hipLaunchCooperativeKernel((const void*)mega, dim3(grid_blocks), dim3(512), args, LDS_BYTES, stream);
    if (e != hipSuccess) fprintf(stderr, "cooperative launch failed: %s (grid %d)\n", hipGetErrorString(e), grid_blocks);
#endif
}
```

```cpp
#include <hip/hip_runtime.h>
#include <hip/hip_cooperative_groups.h>
#include <cstdio>
namespace cg = cooperative_groups;

#ifndef MULTI_LAUNCH
#define MULTI_LAUNCH 0
#endif
#ifndef REPMASK
#define REPMASK 0
#endif

#define LAS __attribute__((address_space(3)))
typedef unsigned short bf16_t;
typedef short bf16x8 __attribute__((ext_vector_type(8)));
typedef float f32x2 __attribute__((ext_vector_type(2)));
typedef float f32x4 __attribute__((ext_vector_type(4)));
typedef float f32x16 __attribute__((ext_vector_type(16)));
typedef unsigned u32x2 __attribute__((ext_vector_type(2)));
typedef unsigned u32x4 __attribute__((ext_vector_type(4)));

constexpr int D = 1024, NTOK = 16384, NCTX = 8192, DFF = 2816, NFF1 = 5632;
constexpr float ALPHA = 1.681792830507429f;
constexpr float LN_EPS = 1e-5f;
constexpr int LDS_BYTES = 131072 + 16;
constexpr int NPH = 30;
constexpr int XCD_BAR_WORDS_C = 3456;
constexpr int LDS_ST_OFF = 131072;

constexpr size_t WS_W1 = 0;
constexpr size_t WS_W2 = WS_W1 + (size_t)4 * 5632 * 1024 * 2;
constexpr size_t WS_WG = WS_W2 + (size_t)4 * 1024 * 2816 * 2;
constexpr size_t WS_WP = WS_WG + (size_t)2 * 2048 * 1024 * 2;
constexpr size_t WS_MOD = WS_WP + (size_t)2 * 4 * 256 * 256 * 2;
constexpr size_t WS_ST = WS_MOD + (size_t)4 * 5 * 6144 * 4;
constexpr size_t WS_Z = WS_ST + (size_t)NTOK * 64 * 4;
constexpr size_t WS_Y = WS_Z + (size_t)NTOK * D * 4;
constexpr size_t WS_P = WS_Y + (size_t)2 * NTOK * D * 4;
constexpr size_t WS_Q = WS_P + (size_t)NTOK * D * 2;
constexpr size_t WS_BAR = WS_Q + (size_t)NTOK * D * 2;
constexpr size_t WS_E = WS_BAR + (size_t)XCD_BAR_WORDS_C * 4;
constexpr size_t WS_END = WS_E + (size_t)32 * 2 * 64 * 64 * 8;

struct Params {
    const float* in[25];
    float* out;
    unsigned char* ws;
    int ph_lo, ph_hi;
};

__device__ __forceinline__ unsigned cvt_pk_bf16(float lo, float hi) { unsigned r; asm("v_cvt_pk_bf16_f32 %0, %1, %2" : "=v"(r) : "v"(lo), "v"(hi)); return r; }
__device__ __forceinline__ float bf_lo(unsigned w) { return __uint_as_float(w << 16); }
__device__ __forceinline__ float bf_hi(unsigned w) { return __uint_as_float(w & 0xffff0000u); }
__device__ __forceinline__ float sigmoidf_(float x) { return __builtin_amdgcn_rcpf(1.0f + __expf(-x)); }
__device__ __forceinline__ float gelu_tanh(float x) { const float a = 1.5957691216057308f * (x + 0.044715f * x * x * x); return x * sigmoidf_(a); }
__device__ __forceinline__ int opaque_tid() { int t = threadIdx.x; asm volatile("" : "+v"(t)); return t; }
__device__ __forceinline__ int opaque_bid() { int b = blockIdx.x; asm volatile("" : "+s"(b)); return b; }
__device__ __forceinline__ int opaque_s(int v) { asm volatile("" : "+s"(v)); return v; }
__device__ __forceinline__ int cond_of_row(int row) { return row < NCTX ? 0 : 1 + ((row - NCTX) >> 11); }


#define XB_TMO      128
#define XB_XCNT(j)  (256  + 64 * (j))
#define XB_XSUB(j)  (1280 + 64 * (j))
#define XB_XGEN(j)  (2304 + 64 * (j))
#define XB_TOP      3328
#define XB_TOPGEN   3392
#define XCD_BAR_WORDS 3456
#define XB_SPIN_CAP (1u << 20)
__device__ __forceinline__ unsigned xb_ld(unsigned* p)              { return __hip_atomic_load(p, __ATOMIC_RELAXED, __HIP_MEMORY_SCOPE_AGENT); }
__device__ __forceinline__ unsigned xb_add(unsigned* p, unsigned v) { return __hip_atomic_fetch_add(p, v, __ATOMIC_RELAXED, __HIP_MEMORY_SCOPE_AGENT); }
__device__ __forceinline__ unsigned xb_xcc_id() { return (unsigned)__builtin_amdgcn_s_getreg((3 << 11) | 20) & 0xFu; }
#define XB_SPIN(cond, bar) do { unsigned _sp = 0; while (cond) { __builtin_amdgcn_s_sleep(1); \
    if ((++_sp & 255u) == 0u) { if (xb_ld(&(bar)[XB_TMO])) break; if (_sp > XB_SPIN_CAP) { atomicAdd(&(bar)[XB_TMO], 1u); break; } } } } while (0)
struct XcdBarrier { unsigned* bar; unsigned x; volatile LAS unsigned* st; };
__device__ __forceinline__ XcdBarrier xcd_barrier_post(unsigned* bar, volatile LAS unsigned* st) {
    XcdBarrier b; b.bar = bar; b.x = xb_xcc_id(); b.st = st;
    if (threadIdx.x == 0) (void)xb_add(&bar[XB_XCNT(b.x)], 1u);
    return b;
}
__device__ __forceinline__ void xcd_barrier_complete(unsigned* bar, unsigned x, unsigned& nloc, unsigned& nx) {
    const unsigned G = gridDim.x * gridDim.y * gridDim.z;
    unsigned sum, cnt, mine, sp = 0u;
    for (;;) {
        sum = 0u; cnt = 0u; mine = 0u;
#pragma unroll
        for (unsigned j = 0; j < 16; ++j) { const unsigned c = xb_ld(&bar[XB_XCNT(j)]); sum += c; cnt += (c > 0u) ? 1u : 0u; mine = (j == x) ? c : mine; }
        if (sum == G) break;
        __builtin_amdgcn_s_sleep(1);
        if ((++sp & 255u) == 0u) { if (xb_ld(&bar[XB_TMO])) break; if (sp > XB_SPIN_CAP) { atomicAdd(&bar[XB_TMO], 1u); break; } }
    }
    nloc = mine > 0u ? mine : 1u; nx = cnt > 0u ? cnt : 1u;
}
__device__ __forceinline__ void xcd_barrier(const XcdBarrier& b) {
    asm volatile("s_waitcnt vmcnt(0)" ::: "memory");
    __syncthreads();
    if (threadIdx.x == 0) {
        unsigned* bar = b.bar;
        __builtin_amdgcn_s_waitcnt(0);
        unsigned nloc = b.st[0], nx = b.st[1];
        if (nloc == 0u) { xcd_barrier_complete(bar, b.x, nloc, nx); b.st[0] = nloc; b.st[1] = nx; }
        const unsigned old = xb_add(&bar[XB_XSUB(b.x)], 1u);
        const unsigned gen = old / nloc;
        if (old + 1u == (gen + 1u) * nloc) {
            __builtin_amdgcn_fence(__ATOMIC_RELEASE, "agent");
            asm volatile("s_waitcnt vmcnt(0)" ::: "memory");
            const unsigned og = xb_add(&bar[XB_TOP], 1u);
            const unsigned tg = og / nx;
            if (og + 1u == (tg + 1u) * nx) xb_add(&bar[XB_TOPGEN], 1u);
            else XB_SPIN(xb_ld(&bar[XB_TOPGEN]) == tg, bar);
            __builtin_amdgcn_fence(__ATOMIC_ACQUIRE, "agent");
            xb_add(&bar[XB_XGEN(b.x)], 1u);
            asm volatile("s_waitcnt vmcnt(0)" ::: "memory");
        } else {
            XB_SPIN(xb_ld(&bar[XB_XGEN(b.x)]) == gen, bar);
            __builtin_amdgcn_fence(__ATOMIC_ACQUIRE, "agent");
            asm volatile("s_waitcnt vmcnt(0)" ::: "memory");
        }
    }
    __syncthreads();
}

__device__ __forceinline__ void adaln_item(const Params& p, int it, LAS float* lds) {
    const int tid = opaque_tid();
    const int layer = it / 96, c0 = (it % 96) * 64;
    LAS float* s = lds;
    LAS float* red = lds + 5120;
    for (int e = tid; e < 5120; e += 512) { const int cnd = e >> 10, k = e & 1023; const float v = cnd == 0 ? p.in[5][k] : p.in[4][(cnd - 1) * 1024 + k]; s[e] = v * sigmoidf_(v); }
    __syncthreads();
    const int cgp = tid & 15, ks = tid >> 4;
    f32x4 acc[5];
#pragma unroll
    for (int c = 0; c < 5; ++c) acc[c] = (f32x4){0.f, 0.f, 0.f, 0.f};
    const float* base = p.in[6] + (size_t)layer * 1024 * 6144 + c0 + cgp * 4;
#pragma unroll 8
    for (int kk = 0; kk < 32; ++kk) { const int k = ks * 32 + kk; const f32x4 w = *(const f32x4*)(base + (size_t)k * 6144);
#pragma unroll
        for (int c = 0; c < 5; ++c) acc[c] += s[c * 1024 + k] * w; }
#pragma unroll
    for (int c = 0; c < 5; ++c) *(LAS f32x4*)(red + (ks * 5 + c) * 64 + cgp * 4) = acc[c];
    __syncthreads();
    if (tid < 320) { const int cnd = tid >> 6, col = tid & 63; float a = p.in[7][layer * 6144 + c0 + col];
        for (int k2 = 0; k2 < 32; ++k2) a += red[(k2 * 5 + cnd) * 64 + col];
        ((float*)(p.ws + WS_MOD))[(layer * 5 + cnd) * 6144 + c0 + col] = a; }
    __syncthreads();
}

struct TJob { const float* srcA; const float* srcB; bf16_t* dst; int src_ld, dst_ld, k0, c0; bool inter; };
struct WPtrs { const float* gate; const float* up; const float* down; const float* glu; const float* pool; unsigned char* ws; };
__device__ __forceinline__ TJob decode_job(const WPtrs& p, int idx) {
    TJob j;
    if (idx < 5632) { const int layer = idx / 1408, r = idx % 1408, kt = r / 88, ct = r % 88;
        j.srcA = p.gate + (size_t)layer * 1024 * 2816; j.srcB = p.up + (size_t)layer * 1024 * 2816; j.src_ld = 2816; j.k0 = kt * 64; j.c0 = ct * 64; j.inter = true; j.dst = (bf16_t*)(p.ws + WS_W1) + (size_t)layer * 5632 * 1024; j.dst_ld = 1024;
    } else if (idx < 8448) { const int r0 = idx - 5632, layer = r0 / 704, r = r0 % 704, kt = r / 16, ct = r % 16;
        j.srcA = p.down + (size_t)layer * 2816 * 1024; j.srcB = j.srcA; j.src_ld = 1024; j.k0 = kt * 64; j.c0 = ct * 64; j.inter = false; j.dst = (bf16_t*)(p.ws + WS_W2) + (size_t)layer * 1024 * 2816; j.dst_ld = 2816;
    } else if (idx < 9472) { const int r0 = idx - 8448, jj = r0 / 512, r = r0 % 512, kt = r / 32, ct = r % 32;
        j.srcA = p.glu + (size_t)jj * 1024 * 2048; j.srcB = j.srcA + 1024; j.src_ld = 2048; j.k0 = kt * 64; j.c0 = ct * 64; j.inter = true; j.dst = (bf16_t*)(p.ws + WS_WG) + (size_t)jj * 2048 * 1024; j.dst_ld = 1024;
    } else { const int r0 = idx - 9472, jg = r0 / 16, r = r0 % 16, kt = r / 4, ct = r % 4;
        j.srcA = p.pool + (size_t)jg * 65536; j.srcB = j.srcA; j.src_ld = 256; j.k0 = kt * 64; j.c0 = ct * 64; j.inter = false; j.dst = (bf16_t*)(p.ws + WS_WP) + (size_t)jg * 65536; j.dst_ld = 256; }
    return j;
}
__device__ __forceinline__ int job_idx(int list, int j) {
    if (list == 0) { if (j < 1408) return j; if (j < 2112) return 5632 + (j - 1408); if (j < 3136) return 8448 + (j - 2112); return 9472 + (j - 3136); }
    return j < 1408 ? list * 1408 + j : 5632 + list * 704 + (j - 1408);
}
__device__ __forceinline__ void transpose_list(const Params& pp, LAS float* lds, int list, int nj, int first, int stride) {
    const WPtrs p{pp.in[22], pp.in[23], pp.in[24], pp.in[18], pp.in[20], pp.ws};
    const int tid = opaque_tid(), l64 = tid & 63, kk0 = tid >> 6, c = tid >> 3, ks = tid & 7;
    for (int base = first; base < nj; base += 4 * stride) {
        float vals[4][8]; int cl[4];
#pragma unroll
        for (int q = 0; q < 4; ++q) { const int jn = base + q * stride;
            if (jn < nj) { const TJob j = decode_job(p, job_idx(list, jn)); const float* sp;
                if (j.inter) { const int n = l64 >> 5, oo = l64 & 31; sp = (n ? j.srcB : j.srcA) + (j.c0 >> 1) + oo; cl[q] = (oo >> 4) * 32 + n * 16 + (oo & 15); }
                else { sp = j.srcA + j.c0 + l64; cl[q] = l64; }
#pragma unroll
                for (int i8 = 0; i8 < 8; ++i8) vals[q][i8] = sp[(size_t)(j.k0 + kk0 + i8 * 8) * j.src_ld]; } }
#pragma unroll
        for (int q = 0; q < 4; ++q) { if (base + q * stride < nj) {
#pragma unroll
                for (int i8 = 0; i8 < 8; ++i8) lds[q * 4160 + (kk0 + i8 * 8) * 65 + cl[q]] = vals[q][i8]; } }
        __syncthreads();
#pragma unroll
        for (int q = 0; q < 4; ++q) { const int jn = base + q * stride;
            if (jn < nj) { const TJob j = decode_job(p, job_idx(list, jn)); float v[8];
#pragma unroll
                for (int e = 0; e < 8; ++e) v[e] = lds[q * 4160 + (ks * 8 + e) * 65 + c];
                u32x4 w; w.x = cvt_pk_bf16(v[0], v[1]); w.y = cvt_pk_bf16(v[2], v[3]); w.z = cvt_pk_bf16(v[4], v[5]); w.w = cvt_pk_bf16(v[6], v[7]);
                *(u32x4*)(j.dst + (size_t)(j.c0 + c) * j.dst_ld + j.k0 + ks * 8) = w; } }
        __syncthreads();
    }
}
__device__ __forceinline__ void phase_w0(const Params& p, LAS unsigned char* lds8) {
    LAS float* lds = (LAS float*)lds8;
    const int NADA = 384, G = gridDim.x;
    const int bid = opaque_bid();
    for (int it = bid; it < NADA; it += G) adaln_item(p, it, lds);
    transpose_list(p, lds, 0, 3264, bid, G);
}
__device__ __forceinline__ void deferred_weights(const Params& p, LAS unsigned char* lds8, int list, int nunits) {
    const int G = gridDim.x, rem = nunits % G, c = opaque_bid();
    if (rem == 0) transpose_list(p, (LAS float*)lds8, list, 2112, c, G);
    else if (c >= rem) transpose_list(p, (LAS float*)lds8, list, 2112, c - rem, G - rem);
}

__device__ __forceinline__ void store_bf16x8(bf16_t* dst, const f32x4 a, const f32x4 b) {
    u32x4 w; w.x = cvt_pk_bf16(a[0], a[1]); w.y = cvt_pk_bf16(a[2], a[3]); w.z = cvt_pk_bf16(b[0], b[1]); w.w = cvt_pk_bf16(b[2], b[3]);
    *(u32x4*)dst = w;
}

__device__ __forceinline__ void phase_prep0(const Params& p) {
    const int tid_ = opaque_tid(), bid_ = opaque_bid(); const int wid = tid_ >> 6, lane = tid_ & 63;
    const float* mod = (const float*)(p.ws + WS_MOD);
    bf16_t* P = (bf16_t*)(p.ws + WS_P);
    for (int g4 = bid_ * 8 + wid; g4 < NTOK / 4; g4 += gridDim.x * 8) {
        const int row0 = g4 * 4; const int cnd = cond_of_row(row0);
        const float* src = row0 < NCTX ? p.in[0] + (size_t)row0 * D : p.in[1] + (size_t)(row0 - NCTX) * D;
        const float* sh = mod + (0 * 5 + cnd) * 6144, *sc = sh + 1024;
        f32x4 x[4][2][2];
#pragma unroll
        for (int r = 0; r < 4; ++r)
#pragma unroll
            for (int j = 0; j < 2; ++j) { const int col = j * 512 + lane * 8; x[r][j][0] = *(const f32x4*)(src + r * D + col); x[r][j][1] = *(const f32x4*)(src + r * D + col + 4); }
#pragma unroll
        for (int j = 0; j < 2; ++j) { const int col = j * 512 + lane * 8;
            const f32x4 s0 = 1.0f + *(const f32x4*)(sc + col), s1 = 1.0f + *(const f32x4*)(sc + col + 4), b0 = *(const f32x4*)(sh + col), b1 = *(const f32x4*)(sh + col + 4);
#pragma unroll
            for (int r = 0; r < 4; ++r) store_bf16x8(P + (size_t)(row0 + r) * D + col, x[r][j][0] * s0 + b0, x[r][j][1] * s1 + b1); }
    }
}

__device__ __forceinline__ void phase_ln(const Params& p, int layer, int which, int npart, bool wrP) {
    const int tid_ = opaque_tid(), bid_ = opaque_bid(); const int wid = tid_ >> 6, lane = tid_ & 63;
    const float* mod = (const float*)(p.ws + WS_MOD);
    const float* Z = (const float*)(p.ws + WS_Z);
    const f32x2* ST = (const f32x2*)(p.ws + WS_ST);
    float* X = p.out;
    const float* lg = p.in[8] + (layer * 2 + which) * 1024, *lb = p.in[9] + (layer * 2 + which) * 1024;
    for (int g4 = bid_ * 8 + wid; g4 < NTOK / 4; g4 += gridDim.x * 8) {
        const int row0 = g4 * 4;
        f32x2 st[4]; f32x4 z[4][2][2];
#pragma unroll
        for (int r = 0; r < 4; ++r) { st[r] = lane < npart ? ST[(size_t)(row0 + r) * 32 + lane] : (f32x2){0.f, 0.f};
#pragma unroll
            for (int j = 0; j < 2; ++j) { const size_t off = (size_t)(row0 + r) * D + j * 512 + lane * 8; z[r][j][0] = *(const f32x4*)(Z + off); z[r][j][1] = *(const f32x4*)(Z + off + 4); } }
        float mean[4], rstd[4];
#pragma unroll
        for (int r = 0; r < 4; ++r) {
#pragma unroll
            for (int o = 1; o < 64; o <<= 1) { st[r].x += __shfl_xor(st[r].x, o); st[r].y += __shfl_xor(st[r].y, o); }
            mean[r] = st[r].x * (1.0f / 1024.0f); const float var = fmaxf(st[r].y * (1.0f / 1024.0f) - mean[r] * mean[r], 0.f); rstd[r] = rsqrtf(var + LN_EPS); }
        const int cnd = cond_of_row(row0);
        const float* sh = nullptr; const float* sc = nullptr; bf16_t* dst = nullptr;
        if (which == 0) { sh = mod + (layer * 5 + cnd) * 6144 + 3 * 1024; sc = sh + 1024; dst = (bf16_t*)(p.ws + WS_Q); }
        else if (wrP) { sh = mod + ((layer + 1) * 5 + cnd) * 6144; sc = sh + 1024; dst = (bf16_t*)(p.ws + WS_P); }
#pragma unroll
        for (int j = 0; j < 2; ++j) { const int col = j * 512 + lane * 8;
            const f32x4 g0 = *(const f32x4*)(lg + col), g1 = *(const f32x4*)(lg + col + 4), b0 = *(const f32x4*)(lb + col), b1 = *(const f32x4*)(lb + col + 4);
            f32x4 s0 = {0.f, 0.f, 0.f, 0.f}, s1 = s0, h0 = s0, h1 = s0;
            if (dst) { s0 = 1.0f + *(const f32x4*)(sc + col); s1 = 1.0f + *(const f32x4*)(sc + col + 4); h0 = *(const f32x4*)(sh + col); h1 = *(const f32x4*)(sh + col + 4); }
#pragma unroll
            for (int r = 0; r < 4; ++r) { const size_t off = (size_t)(row0 + r) * D + col;
                const f32x4 x0 = (z[r][j][0] - mean[r]) * rstd[r] * g0 + b0, x1 = (z[r][j][1] - mean[r]) * rstd[r] * g1 + b1;
                *(f32x4*)(X + off) = x0; *(f32x4*)(X + off + 4) = x1;
                if (dst) store_bf16x8(dst + off, x0 * s0 + h0, x1 * s1 + h1); } }
    }
}

__device__ __forceinline__ void phase_comb(const Params& p, int jj) {
    const int tid_ = opaque_tid(), bid_ = opaque_bid(); const int wid = tid_ >> 6, lane = tid_ & 63;
    const bf16_t* P = (const bf16_t*)(p.ws + WS_P);
    const float* YF = (const float*)(p.ws + WS_Y), *YB = YF + (size_t)NTOK * D;
    bf16_t* Q = (bf16_t*)(p.ws + WS_Q);
    const float* dsk = p.in[17] + jj * 1024;
    for (int g2 = bid_ * 8 + wid; g2 < NTOK / 2; g2 += gridDim.x * 8) {
        const int row0 = g2 * 2;
        u32x4 uw[2][2]; f32x4 yf[2][2][2], yb[2][2][2];
#pragma unroll
        for (int r = 0; r < 2; ++r)
#pragma unroll
            for (int j = 0; j < 2; ++j) { const size_t off = (size_t)(row0 + r) * D + j * 512 + lane * 8;
                uw[r][j] = *(const u32x4*)(P + off); yf[r][j][0] = *(const f32x4*)(YF + off); yf[r][j][1] = *(const f32x4*)(YF + off + 4); yb[r][j][0] = *(const f32x4*)(YB + off); yb[r][j][1] = *(const f32x4*)(YB + off + 4); }
#pragma unroll
        for (int j = 0; j < 2; ++j) { const int col = j * 512 + lane * 8; const f32x4 d0 = *(const f32x4*)(dsk + col), d1 = *(const f32x4*)(dsk + col + 4);
#pragma unroll
            for (int r = 0; r < 2; ++r) { const u32x4 w = uw[r][j];
                const f32x4 u0 = {bf_lo(w.x), bf_hi(w.x), bf_lo(w.y), bf_hi(w.y)}, u1 = {bf_lo(w.z), bf_hi(w.z), bf_lo(w.w), bf_hi(w.w)};
                f32x4 y0 = u0 * d0 + yf[r][j][0] + yb[r][j][0], y1 = u1 * d1 + yf[r][j][1] + yb[r][j][1];
#pragma unroll
                for (int e = 0; e < 4; ++e) { y0[e] = gelu_tanh(y0[e]); y1[e] = gelu_tanh(y1[e]); }
                store_bf16x8(Q + (size_t)(row0 + r) * D + col, y0, y1); } }
    }
}

template <int K> __device__ __forceinline__ void pool2d_task(const float* X, const float* mod, bf16_t* Q, int layer, int b, int c, int ch) {
    const int clo = max(c - K / 2, 0), chi = min(c - K / 2 + K, 64);
    const size_t tb = (size_t)(NCTX + b * 2048);
    f32x2 hs[32];
#pragma unroll
    for (int r = 0; r < 32; ++r) hs[r] = (f32x2){0.f, 0.f};
    for (int cc = clo; cc < chi; ++cc) {
        const float* xp = X + (tb + cc) * D + ch;
#pragma unroll
        for (int rh = 0; rh < 2; ++rh) {
            f32x2 t_[16];
#pragma unroll
            for (int r = 0; r < 16; ++r) t_[r] = *(const f32x2*)(xp + (size_t)(rh * 16 + r) * 64 * D);
#pragma unroll
            for (int r = 0; r < 16; ++r) hs[rh * 16 + r] += t_[r]; } }
    const f32x2 sc = *(const f32x2*)(mod + (layer * 5 + 1 + b) * 6144 + 1024 + ch);
#pragma unroll
    for (int r = 0; r < 32; ++r) { const int rlo = (r - K / 2) < 0 ? 0 : (r - K / 2), rhi = (r - K / 2 + K) > 32 ? 32 : (r - K / 2 + K);
        f32x2 t = {0.f, 0.f};
#pragma unroll
        for (int rr = rlo; rr < rhi; ++rr) t += hs[rr];
        const float inv = 1.0f / (float)((rhi - rlo) * (chi - clo));
        const size_t off = (tb + r * 64 + c) * D + ch;
        const f32x2 xc = *(const f32x2*)(X + off);
        const f32x2 o = (t * inv - xc) * (1.0f + sc);
        *(unsigned*)(Q + off) = cvt_pk_bf16(o.x, o.y); }
}
template <int K> __device__ __forceinline__ void pool1d_task(const float* X, const float* mod, bf16_t* Q, int layer, int b, int t0, int ch) {
    const size_t tb = (size_t)b * 256;
    f32x2 v[16 + K];
#pragma unroll
    for (int i = 0; i < 16 + K; ++i) { const int t = t0 - K / 2 + i; v[i] = (t >= 0 && t < 256) ? *(const f32x2*)(X + (tb + t) * D + ch) : (f32x2){0.f, 0.f}; }
    const f32x2 sc = *(const f32x2*)(mod + (layer * 5 + 0) * 6144 + 1024 + ch);
#pragma unroll
    for (int i = 0; i < 16; ++i) { const int t = t0 + i; const int lo = max(t - K / 2, 0), hi = min(t - K / 2 + K, 256);
        f32x2 s = {0.f, 0.f};
#pragma unroll
        for (int k2 = 0; k2 < K; ++k2) s += v[i + k2];
        const float inv = 1.0f / (float)(hi - lo);
        const f32x2 o = (s * inv - v[i + K / 2]) * (1.0f + sc);
        *(unsigned*)(Q + (tb + t) * D + ch) = cvt_pk_bf16(o.x, o.y); }
}
__device__ __forceinline__ void phase_poolprep(const Params& p, int layer) {
    const int tid_ = opaque_tid(), bid_ = opaque_bid(); const int wid = tid_ >> 6, lane = tid_ & 63;
    const float* X = p.out; const float* mod = (const float*)(p.ws + WS_MOD); bf16_t* Q = (bf16_t*)(p.ws + WS_Q);
    const int nslots = gridDim.x * 8;
    for (int t = wid * gridDim.x + bid_; t < 2048 + 4096; t += nslots) {
        if (t < 2048) { const int gi = 3 - (t >> 9), r = t & 511, b = r >> 7, c = (r >> 1) & 63, half = r & 1; const int ch = gi * 256 + half * 128 + lane * 2;
            if (gi == 3) pool2d_task<16>(X, mod, Q, layer, b, c, ch); else if (gi == 2) pool2d_task<8>(X, mod, Q, layer, b, c, ch);
            else if (gi == 1) pool2d_task<4>(X, mod, Q, layer, b, c, ch); else pool2d_task<2>(X, mod, Q, layer, b, c, ch);
        } else { const int u = t - 2048; const int gi = 3 - (u >> 10), r = u & 1023, b = r >> 5, seg = (r >> 1) & 15, half = r & 1; const int ch = gi * 256 + half * 128 + lane * 2;
            if (gi == 3) pool1d_task<16>(X, mod, Q, layer, b, seg * 16, ch); else if (gi == 2) pool1d_task<8>(X, mod, Q, layer, b, seg * 16, ch);
            else if (gi == 1) pool1d_task<4>(X, mod, Q, layer, b, seg * 16, ch); else pool1d_task<2>(X, mod, Q, layer, b, seg * 16, ch);
        }
    }
}

constexpr int S5_ROWB = 272;
constexpr int S5_WAVE_LDS = 32 * S5_ROWB;

template <int MODE>
__device__ __forceinline__ void s5_task(const Params& p, int jj, int task, LAS unsigned char* wl, int lane) {
    const int pair = task >> 7, dir = (task >> 6) & 1, g = task & 63;
    constexpr int L = 256, ntile = 16;
    const int half = lane >> 5, p0 = lane & 31;
    const int pidx = (jj * 2 + dir) * 64 + g;
    const float dt = expf(p.in[12][pidx]);
    float ar[2], ai[2]; bf16x8 Bre[2], Bim[2];
#pragma unroll
    for (int s = 0; s < 2; ++s) { const int P = p0 + 32 * s;
        const float are = p.in[10][pidx * 64 + P], aim = p.in[11][pidx * 64 + P];
        const float mag = expf(are * dt), ang = aim * dt; float sn, cs; sn = sinf(ang); cs = cosf(ang);
        const float abr = mag * cs, abi = mag * sn, den = are * are + aim * aim, nr = abr - 1.0f;
        const float cr = (nr * are + abi * aim) / den, ci = (abi * are - nr * aim) / den;
        const float* br = p.in[13] + ((size_t)(pidx * 64 + P) * 16 + half * 8), *bi = p.in[14] + ((size_t)(pidx * 64 + P) * 16 + half * 8);
        const f32x4 br0 = *(const f32x4*)br, br1 = *(const f32x4*)(br + 4), bi0 = *(const f32x4*)bi, bi1 = *(const f32x4*)(bi + 4);
        const f32x4 r0 = cr * br0 - ci * bi0, r1 = cr * br1 - ci * bi1, i0 = cr * bi0 + ci * br0, i1 = cr * bi1 + ci * br1;
        u32x4 wr_, wi_;
        wr_.x = cvt_pk_bf16(r0[0], r0[1]); wr_.y = cvt_pk_bf16(r0[2], r0[3]); wr_.z = cvt_pk_bf16(r1[0], r1[1]); wr_.w = cvt_pk_bf16(r1[2], r1[3]);
        wi_.x = cvt_pk_bf16(i0[0], i0[1]); wi_.y = cvt_pk_bf16(i0[2], i0[3]); wi_.z = cvt_pk_bf16(i1[0], i1[1]); wi_.w = cvt_pk_bf16(i1[2], i1[3]);
        Bre[s] = __builtin_bit_cast(bf16x8, wr_); Bim[s] = __builtin_bit_cast(bf16x8, wi_);
        ar[s] = abr; ai[s] = abi; }
    const int csc = pair * 2 + half;
    f32x2* E = (f32x2*)(p.ws + WS_E);
    float sr[2], si[2];
#pragma unroll
    for (int s = 0; s < 2; ++s) { sr[s] = 0.f; si[s] = 0.f; }
    if (MODE == 2) {
        const int b = csc >> 3, k = csc & 7;
#pragma unroll
        for (int s = 0; s < 2; ++s) { const int P = p0 + 32 * s;
            float qr = ar[s], qi = ai[s];
#pragma unroll
            for (int e = 0; e < 8; ++e) { const float t = qr * qr - qi * qi; qi = 2.0f * qr * qi; qr = t; }
            const size_t ix = ((size_t)((b * 2 + jj) * 2 + dir) * 64 + g) * 64 + P;
            float hr = p.in[2][ix], hi = p.in[3][ix];
            for (int e = 0; e < 7; ++e) { const int kk = dir ? 7 - e : e;
                const bool pre = dir ? (kk > k) : (kk < k);
                const f32x2 ev = E[((size_t)((b * 8 + kk) * 2 + dir) * 64 + g) * 64 + P];
                if (pre) { const float t = qr * hr - qi * hi + ev.x; hi = qr * hi + qi * hr + ev.y; hr = t; } }
            sr[s] = hr; si[s] = hi; }
    }
    bf16x8 Cop[4];
    if (MODE != 1) { const int n = lane & 15, kq = lane >> 4;
#pragma unroll
      for (int ks = 0; ks < 4; ++ks) { const int pp = ks * 16 + kq * 4;
          const f32x4 cre = *(const f32x4*)(p.in[15] + ((size_t)(pidx * 16 + n) * 64 + pp)), cim = *(const f32x4*)(p.in[16] + ((size_t)(pidx * 16 + n) * 64 + pp));
          u32x4 w; w.x = cvt_pk_bf16(cre[0], -cim[0]); w.y = cvt_pk_bf16(cre[1], -cim[1]); w.z = cvt_pk_bf16(cre[2], -cim[2]); w.w = cvt_pk_bf16(cre[3], -cim[3]);
          Cop[ks] = __builtin_bit_cast(bf16x8, w); } }
    const int m = lane & 31, lc = (m >> 2) & 1, ltau = ((m >> 3) << 2) | (m & 3), kh = lane >> 5;
    const int lch = pair * 2 + lc; const int lbase = MODE == 0 ? lch * 256 : NCTX + lch * 256;
    const bf16_t* Pu = (const bf16_t*)(p.ws + WS_P) + g * 16 + kh * 8;
    float* Yd = (float*)(p.ws + WS_Y) + (size_t)dir * NTOK * D + g * 16 + (lane >> 4) * 4;
    const int otau = lane & 15;
    auto tok_of = [&](int base, int ti, int tau) { const int step = ti * 16 + tau; return base + (dir ? (L - 1 - step) : step); };
    bf16x8 u0 = *(const bf16x8*)(Pu + (size_t)tok_of(lbase, 0, ltau) * D);
    bf16x8 u1 = *(const bf16x8*)(Pu + (size_t)tok_of(lbase, 1, ltau) * D);
    const f32x16 zero16 = {0.f, 0.f, 0.f, 0.f, 0.f, 0.f, 0.f, 0.f, 0.f, 0.f, 0.f, 0.f, 0.f, 0.f, 0.f, 0.f};
    for (int ti = 0; ti < ntile; ++ti) {
        const int tn = min(ti + 2, ntile - 1);
        const bf16x8 u2 = *(const bf16x8*)(Pu + (size_t)tok_of(lbase, tn, ltau) * D);
        f32x16 dre[2], dim_[2];
#pragma unroll
        for (int s = 0; s < 2; ++s) { dre[s] = __builtin_amdgcn_mfma_f32_32x32x16_bf16(u0, Bre[s], zero16, 0, 0, 0); dim_[s] = __builtin_amdgcn_mfma_f32_32x32x16_bf16(u0, Bim[s], zero16, 0, 0, 0); }
        float x0r = sr[0], x0i = si[0], x1r = sr[1], x1i = si[1];
#pragma unroll
        for (int i = 0; i < 16; ++i) {
            const float n0r = fmaf(ar[0], x0r, fmaf(-ai[0], x0i, dre[0][i])), n0i = fmaf(ar[0], x0i, fmaf(ai[0], x0r, dim_[0][i]));
            const float n1r = fmaf(ar[1], x1r, fmaf(-ai[1], x1i, dre[1][i])), n1i = fmaf(ar[1], x1i, fmaf(ai[1], x1r, dim_[1][i]));
            x0r = n0r; x0i = n0i; x1r = n1r; x1i = n1i;
            if (MODE != 1) { *(LAS unsigned*)(wl + (half * 16 + i) * S5_ROWB + p0 * 4) = cvt_pk_bf16(x0r, x0i);
                             *(LAS unsigned*)(wl + (half * 16 + i) * S5_ROWB + (p0 + 32) * 4) = cvt_pk_bf16(x1r, x1i); }
        }
        sr[0] = x0r; si[0] = x0i; sr[1] = x1r; si[1] = x1i;
        if (MODE != 1) {
            asm volatile("s_waitcnt lgkmcnt(0)" ::: "memory");
            __builtin_amdgcn_wave_barrier();
#pragma unroll
            for (int c = 0; c < 2; ++c) { f32x4 acc = {0.f, 0.f, 0.f, 0.f};
#pragma unroll
                for (int ks = 0; ks < 4; ++ks) { const bf16x8 sf = *(const LAS bf16x8*)(wl + (c * 16 + otau) * S5_ROWB + ks * 64 + (lane >> 4) * 16);
                    acc = __builtin_amdgcn_mfma_f32_16x16x32_bf16(Cop[ks], sf, acc, 0, 0, 0); }
                const int och = pair * 2 + c; const int obase = MODE == 0 ? och * 256 : NCTX + och * 256;
                *(f32x4*)(Yd + (size_t)tok_of(obase, ti, otau) * D) = acc; }
            asm volatile("s_waitcnt lgkmcnt(0)" ::: "memory");
            __builtin_amdgcn_wave_barrier();
        }
        u0 = u1; u1 = u2;
    }
    if (MODE == 0) { float* ore = p.out + (size_t)NTOK * D, *oim = ore + 32 * 2 * 2 * 64 * 64;
#pragma unroll
        for (int s = 0; s < 2; ++s) { const size_t ix = ((size_t)((csc * 2 + jj) * 2 + dir) * 64 + g) * 64 + p0 + 32 * s; ore[ix] = sr[s]; oim[ix] = si[s]; } }
    if (MODE == 1) {
#pragma unroll
        for (int s = 0; s < 2; ++s) E[((size_t)(csc * 2 + dir) * 64 + g) * 64 + p0 + 32 * s] = (f32x2){sr[s], si[s]}; }
}

__device__ __forceinline__ void phase_s5(const Params& p, int jj, int sub, LAS unsigned char* lds) {
    const int tid_ = opaque_tid(), bid_ = opaque_bid(); const int wid = tid_ >> 6, lane = tid_ & 63;
    const int G = gridDim.x, nslots = G * 8, slot = wid * G + bid_;
    LAS unsigned char* wl = lds + wid * S5_WAVE_LDS;
    if (sub == 0) { for (int t = slot; t < 4096; t += nslots) { if (t < 2048) s5_task<1>(p, jj, t, wl, lane); else s5_task<0>(p, jj, t - 2048, wl, lane); } }
    else { for (int t = slot; t < 2048; t += nslots) s5_task<2>(p, jj, t, wl, lane); }
}

namespace pg8 {
constexpr int BM = 256, BK = 64, HALF = 128, HTB = HALF * BK * 2, NXCD = 8, WGM = 8;
__device__ __forceinline__ int lds_byte(int r, int c) { const int st = (r >> 4) * 2 + (c >> 5), rr = r & 15, cc = c & 31, ob = rr * 64 + cc * 2; return st * 1024 + (ob ^ (((ob >> 9) & 1) << 5)); }
__device__ __forceinline__ void stage_rc(int b, int& R, int& C) { const int st = b / 1024, sb = b % 1024, swz = sb ^ (((sb >> 9) & 1) << 5); R = (st >> 1) * 16 + swz / 64; C = (st & 1) * 32 + (swz % 64) / 2; }
struct Unit { int pm, pn; };
struct Gemm { const bf16_t* A; const bf16_t* Bt; int M, N, K, lda, acol; };
struct StaticOrder {
    int nM, nN, nwg, G, c;
    __device__ void init(int M, int N, int G_, int c_) { nM = M / BM; nN = N / BM; nwg = nM * nN; G = G_; c = c_; }
    __device__ bool next(int i, Unit& u) const {
        const long L = (long)i * G + c; if (L >= nwg) return false;
        int wgid = (int)L; { const int q = nwg / NXCD, r = nwg % NXCD, xcd = wgid % NXCD, off = wgid / NXCD; wgid = (xcd < r ? xcd * (q + 1) : r * (q + 1) + (xcd - r) * q) + off; }
        const int nig = WGM * nN, gid = wgid / nig, fm = gid * WGM, gsz = (nM - fm) < WGM ? (nM - fm) : WGM;
        u.pm = fm + ((wgid % nig) % gsz); u.pn = (wgid % nig) / gsz; return true;
    }
};

template <class Epi>
__device__ __forceinline__ void gemm_phase(LAS unsigned char* lds, const Gemm g, const StaticOrder& S, const Epi& E) {
    const int tid = opaque_tid(), wid = __builtin_amdgcn_readfirstlane(tid >> 6), lane = tid & 63, wr = wid >> 2, wc = wid & 3, fr = lane & 15, fq = lane >> 4;
    const int K = g.K, nt = K / BK, lda = g.lda;
    unsigned voffA[2], voffB[2];
#pragma unroll
    for (int i = 0; i < 2; ++i) { int R, C; stage_rc(tid * 16 + i * 8192, R, C); voffA[i] = (unsigned)(R * lda + C) * 2u; voffB[i] = (unsigned)(R * K + C) * 2u; }
    const size_t kstep = (size_t)(BK * 2);
    const size_t hstepA = (size_t)HALF * lda * 2, hstepB = (size_t)HALF * K * 2;
    const size_t tstepA = 2 * hstepA, tstepB = 2 * hstepB;
    const size_t acolb = (size_t)g.acol * 2;
    const unsigned ldsw = (unsigned)wid * 1024u;
    const int aoff = lds_byte(wr * 64 + fr, fq * 8), boff = lds_byte(wc * 32 + fr, fq * 8);
#define PG8_SA(b, h) (((b) * 2 + (h)) * HTB)
#define PG8_SB(b, h) ((4 + (b) * 2 + (h)) * HTB)
#define PG8_STAGE(bufoff, gbase, voff) do { _Pragma("unroll") for (int _i = 0; _i < 2; ++_i) \
        __builtin_amdgcn_global_load_lds((const unsigned*)((const char*)(gbase) + (voff)[_i]), (LAS unsigned*)(lds + (bufoff) + ldsw + _i * 8192), 16, 0, 0); } while (0)
#define PG8_LDA(dst, b, h) do { _Pragma("unroll") for (int m = 0; m < 4; ++m) _Pragma("unroll") for (int k = 0; k < 2; ++k) dst[m][k] = *(const LAS bf16x8*)(lds + PG8_SA(b, h) + aoff + m * 2048 + k * 1024); } while (0)
#define PG8_LDB(dst, b, h) do { _Pragma("unroll") for (int n = 0; n < 2; ++n) _Pragma("unroll") for (int k = 0; k < 2; ++k) dst[n][k] = *(const LAS bf16x8*)(lds + PG8_SB(b, h) + boff + n * 2048 + k * 1024); } while (0)
#define PG8_MMA(ai, bj, At, Bt) do { __builtin_amdgcn_s_setprio(1); _Pragma("unroll") for (int m = 0; m < 4; ++m) _Pragma("unroll") for (int n = 0; n < 2; ++n) _Pragma("unroll") for (int k = 0; k < 2; ++k) \
        acc[ai][bj][m][n] = __builtin_amdgcn_mfma_f32_16x16x32_bf16(Bt[n][k], At[m][k], acc[ai][bj][m][n], 0, 0, 0); __builtin_amdgcn_s_setprio(0); } while (0)
#define PG8_WAIT_V(n) asm volatile("s_waitcnt vmcnt(" #n ")" ::: "memory")
#define PG8_WAIT_L(n) asm volatile("s_waitcnt lgkmcnt(" #n ")" ::: "memory")
#define PG8_BAR __builtin_amdgcn_s_barrier()
#define PG8_SCHED __builtin_amdgcn_sched_barrier(0)
    Unit cur, nxt; int ui = 0;
    if (!S.next(0, cur)) return;
    f32x4 acc[2][2][4][2];
#pragma unroll
    for (int a = 0; a < 2; ++a)
#pragma unroll
        for (int b = 0; b < 2; ++b)
#pragma unroll
            for (int m = 0; m < 4; ++m)
#pragma unroll
                for (int n = 0; n < 2; ++n) acc[a][b][m][n] = (f32x4){0.f, 0.f, 0.f, 0.f};
    bf16x8 At[4][2], B0[2][2], B1[2][2];
    const char* cA = (const char*)g.A + (size_t)cur.pm * tstepA + (size_t)cur.pn * acolb; const char* cB = (const char*)g.Bt + (size_t)cur.pn * tstepB;
    PG8_STAGE(PG8_SB(0, 0), cB, voffB); PG8_STAGE(PG8_SA(0, 0), cA, voffA); PG8_STAGE(PG8_SB(0, 1), cB + hstepB, voffB); PG8_STAGE(PG8_SA(0, 1), cA + hstepA, voffA);
    if (wr == 1) PG8_BAR;
    PG8_WAIT_V(4); PG8_BAR;
    PG8_STAGE(PG8_SB(1, 0), cB + kstep, voffB); PG8_STAGE(PG8_SA(1, 0), cA + kstep, voffA); PG8_STAGE(PG8_SB(1, 1), cB + hstepB + kstep, voffB);
    PG8_WAIT_V(6); PG8_BAR;
    for (;;) {
        const bool has_next = S.next(ui + 1, nxt);
        const char* nA = has_next ? (const char*)g.A + (size_t)nxt.pm * tstepA + (size_t)nxt.pn * acolb : cA; const char* nB = has_next ? (const char*)g.Bt + (size_t)nxt.pn * tstepB : cB;
        for (int t = 0; t < nt; t += 2) {
            const bool last = (t == nt - 2);
            const char* a1 = cA + (size_t)(t + 1) * kstep;
            const char* a2 = last ? nA : cA + (size_t)(t + 2) * kstep; const char* b2 = last ? nB : cB + (size_t)(t + 2) * kstep;
            const char* a3 = a2 + kstep; const char* b3 = b2 + kstep;
            PG8_LDB(B0, 0, 0); PG8_SCHED; PG8_LDA(At, 0, 0); PG8_STAGE(PG8_SA(1, 1), a1 + hstepA, voffA);
            PG8_WAIT_L(8); PG8_BAR; PG8_WAIT_L(0); PG8_MMA(0, 0, At, B0); PG8_BAR; PG8_SCHED;
            PG8_LDB(B1, 0, 1); PG8_STAGE(PG8_SB(0, 0), b2, voffB);
            PG8_BAR; PG8_WAIT_L(0); PG8_MMA(0, 1, At, B1); PG8_BAR;
            PG8_LDA(At, 0, 1); PG8_STAGE(PG8_SA(0, 0), a2, voffA);
            PG8_BAR; PG8_WAIT_L(0); PG8_MMA(1, 0, At, B0); PG8_BAR; PG8_SCHED;
            PG8_STAGE(PG8_SB(0, 1), b2 + hstepB, voffB);
            PG8_WAIT_V(6); PG8_BAR; PG8_MMA(1, 1, At, B1); PG8_BAR;
            PG8_LDB(B0, 1, 0); PG8_SCHED; PG8_LDA(At, 1, 0); PG8_STAGE(PG8_SA(0, 1), a2 + hstepA, voffA);
            PG8_WAIT_L(8); PG8_BAR; PG8_WAIT_L(0); PG8_MMA(0, 0, At, B0); PG8_BAR; PG8_SCHED;
            PG8_LDB(B1, 1, 1); PG8_STAGE(PG8_SB(1, 0), b3, voffB);
            PG8_BAR; PG8_WAIT_L(0); PG8_MMA(0, 1, At, B1); PG8_BAR;
            PG8_LDA(At, 1, 1); PG8_STAGE(PG8_SA(1, 0), a3, voffA);
            PG8_BAR; PG8_WAIT_L(0); PG8_MMA(1, 0, At, B0); PG8_BAR; PG8_SCHED;
            PG8_STAGE(PG8_SB(1, 1), b3 + hstepB, voffB);
            PG8_WAIT_V(6); PG8_BAR; PG8_MMA(1, 1, At, B1); PG8_BAR;
        }
        E(acc, cur, wr, wc, fr, fq);
        if (!has_next) break;
#pragma unroll
        for (int a = 0; a < 2; ++a)
#pragma unroll
            for (int b = 0; b < 2; ++b)
#pragma unroll
                for (int m = 0; m < 4; ++m)
#pragma unroll
                    for (int n = 0; n < 2; ++n) acc[a][b][m][n] = (f32x4){0.f, 0.f, 0.f, 0.f};
        cur = nxt; cA = nA; cB = nB; ++ui;
    }
    PG8_WAIT_V(0);
    if (wr == 0) PG8_BAR;
    PG8_BAR;
#undef PG8_SA
#undef PG8_SB
#undef PG8_STAGE
#undef PG8_LDA
#undef PG8_LDB
#undef PG8_MMA
#undef PG8_WAIT_V
#undef PG8_WAIT_L
#undef PG8_BAR
#undef PG8_SCHED
}
}

__device__ __forceinline__ void stat_store(float s, float q, f32x2* ST, int row, int part, int fq) {
    s += __shfl_xor(s, 16); s += __shfl_xor(s, 32); q += __shfl_xor(q, 16); q += __shfl_xor(q, 32);
    if (fq == 0) ST[(size_t)row * 32 + part] = (f32x2){s, q};
}
struct EpiGlu {
    const float* bias; const float* xlo; const float* xhi; const float* mod; float* Z; f32x2* ST;
    __device__ __forceinline__ void operator()(const f32x4 (&acc)[2][2][4][2], const pg8::Unit& u, int wr, int wc, int fr, int fq) const {
        const int cnd = u.pm < 32 ? 0 : 1 + ((u.pm - 32) >> 3);
        const float* xb = u.pm < 32 ? xlo : xhi; const float* g1 = mod + cnd * 6144 + 2 * 1024;
        int oc[2]; f32x4 bv[2], bg[2], gv[2];
#pragma unroll
        for (int bj = 0; bj < 2; ++bj) { oc[bj] = (u.pn * 8 + bj * 4 + wc) * 16 + 4 * fq; bv[bj] = *(const f32x4*)(bias + oc[bj]); bg[bj] = *(const f32x4*)(bias + 1024 + oc[bj]); gv[bj] = *(const f32x4*)(g1 + oc[bj]); }
#pragma unroll
        for (int ai = 0; ai < 2; ++ai) {
            f32x4 xr[4][2];
#pragma unroll
            for (int m = 0; m < 4; ++m)
#pragma unroll
                for (int bj = 0; bj < 2; ++bj) xr[m][bj] = *(const f32x4*)(xb + (size_t)(u.pm * 256 + ai * 128 + wr * 64 + m * 16 + fr) * D + oc[bj]);
#pragma unroll
            for (int m = 0; m < 4; ++m) { const int row = u.pm * 256 + ai * 128 + wr * 64 + m * 16 + fr; float s = 0.f, q = 0.f;
#pragma unroll
                for (int bj = 0; bj < 2; ++bj) { const f32x4 v = acc[ai][bj][m][0] + bv[bj], gt = acc[ai][bj][m][1] + bg[bj]; f32x4 o;
#pragma unroll
                    for (int e = 0; e < 4; ++e) o[e] = v[e] * sigmoidf_(gt[e]);
                    const f32x4 z = ALPHA * xr[m][bj] + gv[bj] * o;
                    *(f32x4*)(Z + (size_t)row * D + oc[bj]) = z; s += (z[0] + z[1]) + (z[2] + z[3]); q += (z[0] * z[0] + z[1] * z[1]) + (z[2] * z[2] + z[3] * z[3]); }
                stat_store(s, q, ST, row, u.pn * 4 + wc, fq); }
            asm volatile("" ::: "memory"); }
    }
};
struct EpiFfn1 {
    bf16_t* H;
    __device__ __forceinline__ void operator()(const f32x4 (&acc)[2][2][4][2], const pg8::Unit& u, int wr, int wc, int fr, int fq) const {
#pragma unroll
        for (int ai = 0; ai < 2; ++ai)
#pragma unroll
            for (int m = 0; m < 4; ++m) { const int row = u.pm * 256 + ai * 128 + wr * 64 + m * 16 + fr;
#pragma unroll
                for (int bj = 0; bj < 2; ++bj) { const int oc = (u.pn * 8 + bj * 4 + wc) * 16 + 4 * fq; const f32x4 gt = acc[ai][bj][m][0], up = acc[ai][bj][m][1]; f32x4 h;
#pragma unroll
                    for (int e = 0; e < 4; ++e) h[e] = gt[e] * sigmoidf_(gt[e]) * up[e];
                    u32x2 w; w.x = cvt_pk_bf16(h[0], h[1]); w.y = cvt_pk_bf16(h[2], h[3]); *(u32x2*)(H + (size_t)row * DFF + oc) = w; } }
    }
};
struct EpiRes {
    const float* X; const float* mod; int gchunk; const float* scale; float* Z; f32x2* ST;
    __device__ __forceinline__ void operator()(const f32x4 (&acc)[2][2][4][2], const pg8::Unit& u, int wr, int wc, int fr, int fq) const {
        const int cnd = u.pm < 32 ? 0 : 1 + ((u.pm - 32) >> 3);
        const float* gp = mod + cnd * 6144 + gchunk * 1024;
        const int col0 = u.pn * 256 + wc * 32 + 4 * fq;
        f32x4 gv[2][2];
#pragma unroll
        for (int bj = 0; bj < 2; ++bj)
#pragma unroll
            for (int n = 0; n < 2; ++n) { const int col = col0 + bj * 128 + n * 16; gv[bj][n] = *(const f32x4*)(gp + col); if (scale) gv[bj][n] *= *(const f32x4*)(scale + col); }
#pragma unroll
        for (int ai = 0; ai < 2; ++ai)
#pragma unroll
            for (int mh = 0; mh < 2; ++mh) {
                f32x4 xr[2][2][2];
#pragma unroll
                for (int m2 = 0; m2 < 2; ++m2)
#pragma unroll
                    for (int bj = 0; bj < 2; ++bj)
#pragma unroll
                        for (int n = 0; n < 2; ++n) xr[m2][bj][n] = *(const f32x4*)(X + (size_t)(u.pm * 256 + ai * 128 + wr * 64 + (mh * 2 + m2) * 16 + fr) * D + col0 + bj * 128 + n * 16);
#pragma unroll
                for (int m2 = 0; m2 < 2; ++m2) { const int m = mh * 2 + m2; const int row = u.pm * 256 + ai * 128 + wr * 64 + m * 16 + fr; float s = 0.f, q = 0.f;
#pragma unroll
                    for (int bj = 0; bj < 2; ++bj)
#pragma unroll
                        for (int n = 0; n < 2; ++n) { const int col = col0 + bj * 128 + n * 16;
                            const f32x4 z = ALPHA * xr[m2][bj][n] + gv[bj][n] * acc[ai][bj][m][n];
                            *(f32x4*)(Z + (size_t)row * D + col) = z; s += (z[0] + z[1]) + (z[2] + z[3]); q += (z[0] * z[0] + z[1] * z[1]) + (z[2] * z[2] + z[3] * z[3]); }
                    stat_store(s, q, ST, row, u.pn * 4 + wc, fq); }
                asm volatile("" ::: "memory"); }
    }
};

__device__ __forceinline__ void first_seam(const Params& p, LAS unsigned char* lds) {
    volatile LAS unsigned* xst = (volatile LAS unsigned*)(lds + LDS_ST_OFF);
    if (threadIdx.x == 0) { xst[0] = 0u; xst[1] = 0u; }
    __syncthreads();
    (void)xcd_barrier_post((unsigned*)(p.ws + WS_BAR), xst);
}
__device__ __forceinline__ void later_seam(const Params& p, LAS unsigned char* lds) {
    XcdBarrier xb; xb.bar = (unsigned*)(p.ws + WS_BAR); xb.x = xb_xcc_id(); xb.st = (volatile LAS unsigned*)(lds + LDS_ST_OFF);
    xcd_barrier(xb);
}

__global__ void __launch_bounds__(512) mega(Params p) {
    extern __shared__ __attribute__((aligned(16))) unsigned char lds_raw[];
    LAS unsigned char* lds = (LAS unsigned char*)lds_raw;
    cg::grid_group grid = cg::this_grid();
    int ph = 0;
    if (blockIdx.x == 0) for (int i = threadIdx.x; i < XCD_BAR_WORDS; i += 512) ((unsigned*)(p.ws + WS_BAR))[i] = 0u;
#define PHASE_LOCALS const float* mod = (const float*)(p.ws + WS_MOD); float* Z = (float*)(p.ws + WS_Z); f32x2* ST = (f32x2*)(p.ws + WS_ST); bf16_t* Q = (bf16_t*)(p.ws + WS_Q); bf16_t* Hff = (bf16_t*)(p.ws + WS_Y); pg8::StaticOrder S; const float* lmod = mod + layer * 5 * 6144; (void)Z; (void)ST; (void)Q; (void)Hff; (void)lmod; (void)S
#define PHASE(kind, ...) do { if (ph >= p.ph_lo && ph < p.ph_hi) { for (int r_ = 0; r_ <= ((REPMASK >> (kind)) & 1); ++r_) { { const Params& pp_ = p; { Params p = pp_; asm volatile("" : "+s"(p.ws), "+s"(p.out)); PHASE_LOCALS; __VA_ARGS__; } } if (ph + 1 < p.ph_hi || r_ < ((REPMASK >> (kind)) & 1)) { if (ph == p.ph_lo && r_ == 0) { grid.sync(); first_seam(p, lds); } else later_seam(p, lds); } } } ++ph; } while (0)
    { const int layer = 0; (void)layer;
    PHASE(0, phase_w0(p, lds));
    PHASE(1, phase_prep0(p)); }
    for (int layer_ = 0; layer_ < 4; ++layer_) {
        const int layer = opaque_s(layer_);
        const int jj = layer >> 1;
        if ((layer & 1) == 0) {
            PHASE(2, phase_s5(p, jj, 0, lds));
            PHASE(2, phase_s5(p, jj, 1, lds));
            PHASE(3, phase_comb(p, jj));
            PHASE(4, { pg8::Gemm g{Q, (const bf16_t*)(p.ws + WS_WG) + (size_t)jj * 2048 * 1024, NTOK, 2048, 1024, 1024, 0}; S.init(NTOK, 2048, gridDim.x, opaque_bid());
                    EpiGlu E{p.in[19] + jj * 2048, layer == 0 ? p.in[0] : p.out, layer == 0 ? p.in[1] - (size_t)NCTX * D : p.out, lmod, Z, ST};
                    pg8::gemm_phase(lds, g, S, E); });
            PHASE(5, phase_ln(p, layer, 0, 32, false));
        } else {
            PHASE(6, phase_poolprep(p, layer));
            PHASE(7, { pg8::Gemm g{Q, (const bf16_t*)(p.ws + WS_WP) + (size_t)jj * 4 * 65536, NTOK, 1024, 256, 1024, 256}; S.init(NTOK, 1024, gridDim.x, opaque_bid());
                    EpiRes E{p.out, lmod, 2, p.in[21] + jj * 1024, Z, ST};
                    pg8::gemm_phase(lds, g, S, E); });
            PHASE(5, phase_ln(p, layer, 0, 16, false));
        }
        PHASE(8, { pg8::Gemm g{Q, (const bf16_t*)(p.ws + WS_W1) + (size_t)layer * NFF1 * 1024, NTOK, NFF1, 1024, 1024, 0}; S.init(NTOK, NFF1, gridDim.x, opaque_bid());
                EpiFfn1 E{Hff}; pg8::gemm_phase(lds, g, S, E); if (layer < 3) deferred_weights(p, lds, layer + 1, (NTOK / 256) * (NFF1 / 256)); });
        PHASE(9, { pg8::Gemm g{Hff, (const bf16_t*)(p.ws + WS_W2) + (size_t)layer * 1024 * DFF, NTOK, 1024, DFF, DFF, 0}; S.init(NTOK, 1024, gridDim.x, opaque_bid());
                EpiRes E{p.out, lmod, 5, nullptr, Z, ST}; pg8::gemm_phase(lds, g, S, E); });
        PHASE(10, phase_ln(p, layer, 1, 16, layer == 1));
    }
#undef PHASE
}

extern "C" void kernel_launch(void* const* d_in, const int* in_sizes, int n_in, void* d_out, int out_size, void* d_ws, size_t ws_size, hipStream_t stream) {
    static int grid_blocks = 0;
    if (grid_blocks == 0) {
        if (n_in != 25 || ws_size < WS_END) { fprintf(stderr, "kernel_launch: unexpected n_in %d or ws_size %zu (< %zu)\n", n_in, ws_size, (size_t)WS_END); grid_blocks = -1; return; }
        int dev = 0, cus = 0, per_cu = 0;
        hipGetDevice(&dev);
        hipDeviceGetAttribute(&cus, hipDeviceAttributeMultiprocessorCount, dev);
        if (hipFuncSetAttribute((const void*)mega, hipFuncAttributeMaxDynamicSharedMemorySize, LDS_BYTES) != hipSuccess) { fprintf(stderr, "kernel_launch: hipFuncSetAttribute failed\n"); grid_blocks = -1; return; }
        if (hipOccupancyMaxActiveBlocksPerMultiprocessor(&per_cu, (const void*)mega, 512, LDS_BYTES) != hipSuccess || per_cu < 1) { fprintf(stderr, "kernel_launch: occupancy query failed (%d)\n", per_cu); (void)hipGetLastError(); per_cu = 1; }
        if (per_cu > 1) per_cu = 1;
        grid_blocks = cus * per_cu;
    }
    if (grid_blocks < 0) return;
    Params p{};
    for (int i = 0; i < 25; ++i) p.in[i] = (const float*)d_in[i];
    p.out = (float*)d_out; p.ws = (unsigned char*)d_ws;
#if MULTI_LAUNCH
    for (int ph = 0; ph < NPH; ++ph) { p.ph_lo = ph; p.ph_hi = ph + 1; hipLaunchKernelGGL(mega, dim3(grid_blocks), dim3(512), LDS_BYTES, stream, p); }
#else
    p.ph_lo = 0; p.ph_hi = NPH;
    void* args[] = {&p};
    hipError_t e = hipLaunchCooperativeKernel((const void*)mega, dim3(grid_blocks), dim3(512), args, LDS_BYTES, stream);
    if (e != hipSuccess) fprintf(stderr, "cooperative launch failed: %s (grid %d)\n", hipGetErrorString(e), grid_blocks);
#endif
}
```

```cpp
#include <hip/hip_runtime.h>
#include <hip/hip_cooperative_groups.h>
#include <cstdio>
namespace cg = cooperative_groups;

#ifndef MULTI_LAUNCH
#define MULTI_LAUNCH 0
#endif
#ifndef REPMASK
#define REPMASK 0
#endif

#define LAS __attribute__((address_space(3)))
typedef unsigned short bf16_t;
typedef short bf16x8 __attribute__((ext_vector_type(8)));
typedef float f32x2 __attribute__((ext_vector_type(2)));
typedef float f32x4 __attribute__((ext_vector_type(4)));
typedef float f32x16 __attribute__((ext_vector_type(16)));
typedef unsigned u32x2 __attribute__((ext_vector_type(2)));
typedef unsigned u32x4 __attribute__((ext_vector_type(4)));

constexpr int D = 1024, NTOK = 16384, NCTX = 8192, DFF = 2816, NFF1 = 5632;
constexpr float ALPHA = 1.681792830507429f;
constexpr float LN_EPS = 1e-5f;
constexpr int LDS_BYTES = 131072 + 16;
constexpr int NPH = 28;
constexpr int XCD_BAR_WORDS_C = 3456;
constexpr int LDS_ST_OFF = 131072;

constexpr size_t WS_W1 = 0;
constexpr size_t WS_W2 = WS_W1 + (size_t)4 * 5632 * 1024 * 2;
constexpr size_t WS_WG = WS_W2 + (size_t)4 * 1024 * 2816 * 2;
constexpr size_t WS_WP = WS_WG + (size_t)2 * 2048 * 1024 * 2;
constexpr size_t WS_MOD = WS_WP + (size_t)2 * 4 * 256 * 256 * 2;
constexpr size_t WS_ST = WS_MOD + (size_t)4 * 5 * 6144 * 4;
constexpr size_t WS_Z = WS_ST + (size_t)NTOK * 64 * 4;
constexpr size_t WS_Y = WS_Z + (size_t)NTOK * D * 4;
constexpr size_t WS_P = WS_Y + (size_t)2 * NTOK * D * 4;
constexpr size_t WS_Q = WS_P + (size_t)NTOK * D * 2;
constexpr size_t WS_BAR = WS_Q + (size_t)NTOK * D * 2;
constexpr size_t WS_E = WS_BAR + (size_t)XCD_BAR_WORDS_C * 4;
constexpr size_t WS_END = WS_E + (size_t)32 * 2 * 64 * 64 * 8;

struct Params {
    const float* in[25];
    float* out;
    unsigned char* ws;
    int ph_lo, ph_hi;
};

__device__ __forceinline__ unsigned cvt_pk_bf16(float lo, float hi) { unsigned r; asm("v_cvt_pk_bf16_f32 %0, %1, %2" : "=v"(r) : "v"(lo), "v"(hi)); return r; }
__device__ __forceinline__ float bf_lo(unsigned w) { return __uint_as_float(w << 16); }
__device__ __forceinline__ float bf_hi(unsigned w) { return __uint_as_float(w & 0xffff0000u); }
__device__ __forceinline__ float sigmoidf_(float x) { return __builtin_amdgcn_rcpf(1.0f + __expf(-x)); }
__device__ __forceinline__ float gelu_tanh(float x) { const float a = 1.5957691216057308f * (x + 0.044715f * x * x * x); return x * sigmoidf_(a); }
__device__ __forceinline__ int opaque_tid() { int t = threadIdx.x; asm volatile("" : "+v"(t)); return t; }
__device__ __forceinline__ int opaque_bid() { int b = blockIdx.x; asm volatile("" : "+s"(b)); return b; }
__device__ __forceinline__ int opaque_s(int v) { asm volatile("" : "+s"(v)); return v; }
__device__ __forceinline__ int cond_of_row(int row) { return row < NCTX ? 0 : 1 + ((row - NCTX) >> 11); }


#define XB_TMO      128
#define XB_XCNT(j)  (256  + 64 * (j))
#define XB_XSUB(j)  (1280 + 64 * (j))
#define XB_XGEN(j)  (2304 + 64 * (j))
#define XB_TOP      3328
#define XB_TOPGEN   3392
#define XCD_BAR_WORDS 3456
#define XB_SPIN_CAP (1u << 20)
__device__ __forceinline__ unsigned xb_ld(unsigned* p)              { return __hip_atomic_load(p, __ATOMIC_RELAXED, __HIP_MEMORY_SCOPE_AGENT); }
__device__ __forceinline__ unsigned xb_add(unsigned* p, unsigned v) { return __hip_atomic_fetch_add(p, v, __ATOMIC_RELAXED, __HIP_MEMORY_SCOPE_AGENT); }
__device__ __forceinline__ unsigned xb_xcc_id() { return (unsigned)__builtin_amdgcn_s_getreg((3 << 11) | 20) & 0xFu; }
#define XB_SPIN(cond, bar) do { unsigned _sp = 0; while (cond) { __builtin_amdgcn_s_sleep(1); \
    if ((++_sp & 255u) == 0u) { if (xb_ld(&(bar)[XB_TMO])) break; if (_sp > XB_SPIN_CAP) { atomicAdd(&(bar)[XB_TMO], 1u); break; } } } } while (0)
struct XcdBarrier { unsigned* bar; unsigned x; volatile LAS unsigned* st; };
__device__ __forceinline__ XcdBarrier xcd_barrier_post(unsigned* bar, volatile LAS unsigned* st) {
    XcdBarrier b; b.bar = bar; b.x = xb_xcc_id(); b.st = st;
    if (threadIdx.x == 0) (void)xb_add(&bar[XB_XCNT(b.x)], 1u);
    return b;
}
__device__ __forceinline__ void xcd_barrier_complete(unsigned* bar, unsigned x, unsigned& nloc, unsigned& nx) {
    const unsigned G = gridDim.x * gridDim.y * gridDim.z;
    unsigned sum, cnt, mine, sp = 0u;
    for (;;) {
        sum = 0u; cnt = 0u; mine = 0u;
#pragma unroll
        for (unsigned j = 0; j < 16; ++j) { const unsigned c = xb_ld(&bar[XB_XCNT(j)]); sum += c; cnt += (c > 0u) ? 1u : 0u; mine = (j == x) ? c : mine; }
        if (sum == G) break;
        __builtin_amdgcn_s_sleep(1);
        if ((++sp & 255u) == 0u) { if (xb_ld(&bar[XB_TMO])) break; if (sp > XB_SPIN_CAP) { atomicAdd(&bar[XB_TMO], 1u); break; } }
    }
    nloc = mine > 0u ? mine : 1u; nx = cnt > 0u ? cnt : 1u;
}
__device__ __forceinline__ void xcd_barrier(const XcdBarrier& b) {
    asm volatile("s_waitcnt vmcnt(0)" ::: "memory");
    __syncthreads();
    if (threadIdx.x == 0) {
        unsigned* bar = b.bar;
        __builtin_amdgcn_s_waitcnt(0);
        unsigned nloc = b.st[0], nx = b.st[1];
        if (nloc == 0u) { xcd_barrier_complete(bar, b.x, nloc, nx); b.st[0] = nloc; b.st[1] = nx; }
        const unsigned old = xb_add(&bar[XB_XSUB(b.x)], 1u);
        const unsigned gen = old / nloc;
        if (old + 1u == (gen + 1u) * nloc) {
            __builtin_amdgcn_fence(__ATOMIC_RELEASE, "agent");
            asm volatile("s_waitcnt vmcnt(0)" ::: "memory");
            const unsigned og = xb_add(&bar[XB_TOP], 1u);
            const unsigned tg = og / nx;
            if (og + 1u == (tg + 1u) * nx) xb_add(&bar[XB_TOPGEN], 1u);
            else XB_SPIN(xb_ld(&bar[XB_TOPGEN]) == tg, bar);
            __builtin_amdgcn_fence(__ATOMIC_ACQUIRE, "agent");
            xb_add(&bar[XB_XGEN(b.x)], 1u);
            asm volatile("s_waitcnt vmcnt(0)" ::: "memory");
        } else {
            XB_SPIN(xb_ld(&bar[XB_XGEN(b.x)]) == gen, bar);
            __builtin_amdgcn_fence(__ATOMIC_ACQUIRE, "agent");
            asm volatile("s_waitcnt vmcnt(0)" ::: "memory");
        }
    }
    __syncthreads();
}

__device__ __forceinline__ void adaln_item(const Params& p, int it, LAS float* lds) {
    const int tid = opaque_tid();
    const int layer = it / 96, c0 = (it % 96) * 64;
    LAS float* s = lds;
    LAS float* red = lds + 5120;
    for (int e = tid; e < 5120; e += 512) { const int cnd = e >> 10, k = e & 1023; const float v = cnd == 0 ? p.in[5][k] : p.in[4][(cnd - 1) * 1024 + k]; s[e] = v * sigmoidf_(v); }
    __syncthreads();
    const int cgp = tid & 15, ks = tid >> 4;
    f32x4 acc[5];
#pragma unroll
    for (int c = 0; c < 5; ++c) acc[c] = (f32x4){0.f, 0.f, 0.f, 0.f};
    const float* base = p.in[6] + (size_t)layer * 1024 * 6144 + c0 + cgp * 4;
#pragma unroll 8
    for (int kk = 0; kk < 32; ++kk) { const int k = ks * 32 + kk; const f32x4 w = *(const f32x4*)(base + (size_t)k * 6144);
#pragma unroll
        for (int c = 0; c < 5; ++c) acc[c] += s[c * 1024 + k] * w; }
#pragma unroll
    for (int c = 0; c < 5; ++c) *(LAS f32x4*)(red + (ks * 5 + c) * 64 + cgp * 4) = acc[c];
    __syncthreads();
    if (tid < 320) { const int cnd = tid >> 6, col = tid & 63; float a = p.in[7][layer * 6144 + c0 + col];
        for (int k2 = 0; k2 < 32; ++k2) a += red[(k2 * 5 + cnd) * 64 + col];
        ((float*)(p.ws + WS_MOD))[(layer * 5 + cnd) * 6144 + c0 + col] = a; }
    __syncthreads();
}

struct TJob { const float* srcA; const float* srcB; bf16_t* dst; int src_ld, dst_ld, k0, c0; bool inter; };
struct WPtrs { const float* gate; const float* up; const float* down; const float* glu; const float* pool; unsigned char* ws; };
__device__ __forceinline__ TJob decode_job(const WPtrs& p, int idx) {
    TJob j;
    if (idx < 5632) { const int layer = idx / 1408, r = idx % 1408, kt = r / 88, ct = r % 88;
        j.srcA = p.gate + (size_t)layer * 1024 * 2816; j.srcB = p.up + (size_t)layer * 1024 * 2816; j.src_ld = 2816; j.k0 = kt * 64; j.c0 = ct * 64; j.inter = true; j.dst = (bf16_t*)(p.ws + WS_W1) + (size_t)layer * 5632 * 1024; j.dst_ld = 1024;
    } else if (idx < 8448) { const int r0 = idx - 5632, layer = r0 / 704, r = r0 % 704, kt = r / 16, ct = r % 16;
        j.srcA = p.down + (size_t)layer * 2816 * 1024; j.srcB = j.srcA; j.src_ld = 1024; j.k0 = kt * 64; j.c0 = ct * 64; j.inter = false; j.dst = (bf16_t*)(p.ws + WS_W2) + (size_t)layer * 1024 * 2816; j.dst_ld = 2816;
    } else if (idx < 9472) { const int r0 = idx - 8448, jj = r0 / 512, r = r0 % 512, kt = r / 32, ct = r % 32;
        j.srcA = p.glu + (size_t)jj * 1024 * 2048; j.srcB = j.srcA + 1024; j.src_ld = 2048; j.k0 = kt * 64; j.c0 = ct * 64; j.inter = true; j.dst = (bf16_t*)(p.ws + WS_WG) + (size_t)jj * 2048 * 1024; j.dst_ld = 1024;
    } else { const int r0 = idx - 9472, jg = r0 / 16, r = r0 % 16, kt = r / 4, ct = r % 4;
        j.srcA = p.pool + (size_t)jg * 65536; j.srcB = j.srcA; j.src_ld = 256; j.k0 = kt * 64; j.c0 = ct * 64; j.inter = false; j.dst = (bf16_t*)(p.ws + WS_WP) + (size_t)jg * 65536; j.dst_ld = 256; }
    return j;
}
__device__ __forceinline__ int job_idx(int list, int j) {
    if (list == 0) { if (j < 1408) return j; if (j < 2112) return 5632 + (j - 1408); if (j < 3136) return 8448 + (j - 2112); return 9472 + (j - 3136); }
    return j < 1408 ? list * 1408 + j : 5632 + list * 704 + (j - 1408);
}
__device__ __forceinline__ void transpose_list(const Params& pp, LAS float* lds, int list, int nj, int first, int stride) {
    const WPtrs p{pp.in[22], pp.in[23], pp.in[24], pp.in[18], pp.in[20], pp.ws};
    const int tid = opaque_tid(), l64 = tid & 63, kk0 = tid >> 6, c = tid >> 3, ks = tid & 7;
    for (int base = first; base < nj; base += 4 * stride) {
        float vals[4][8]; int cl[4];
#pragma unroll
        for (int q = 0; q < 4; ++q) { const int jn = base + q * stride;
            if (jn < nj) { const TJob j = decode_job(p, job_idx(list, jn)); const float* sp;
                if (j.inter) { const int n = l64 >> 5, oo = l64 & 31; sp = (n ? j.srcB : j.srcA) + (j.c0 >> 1) + oo; cl[q] = (oo >> 4) * 32 + n * 16 + (oo & 15); }
                else { sp = j.srcA + j.c0 + l64; cl[q] = l64; }
#pragma unroll
                for (int i8 = 0; i8 < 8; ++i8) vals[q][i8] = sp[(size_t)(j.k0 + kk0 + i8 * 8) * j.src_ld]; } }
#pragma unroll
        for (int q = 0; q < 4; ++q) { if (base + q * stride < nj) {
#pragma unroll
                for (int i8 = 0; i8 < 8; ++i8) lds[q * 4160 + (kk0 + i8 * 8) * 65 + cl[q]] = vals[q][i8]; } }
        __syncthreads();
#pragma unroll
        for (int q = 0; q < 4; ++q) { const int jn = base + q * stride;
            if (jn < nj) { const TJob j = decode_job(p, job_idx(list, jn)); float v[8];
#pragma unroll
                for (int e = 0; e < 8; ++e) v[e] = lds[q * 4160 + (ks * 8 + e) * 65 + c];
                u32x4 w; w.x = cvt_pk_bf16(v[0], v[1]); w.y = cvt_pk_bf16(v[2], v[3]); w.z = cvt_pk_bf16(v[4], v[5]); w.w = cvt_pk_bf16(v[6], v[7]);
                *(u32x4*)(j.dst + (size_t)(j.c0 + c) * j.dst_ld + j.k0 + ks * 8) = w; } }
        __syncthreads();
    }
}
__device__ __forceinline__ void phase_w0(const Params& p, LAS unsigned char* lds8) {
    LAS float* lds = (LAS float*)lds8;
    const int NADA = 384, G = gridDim.x;
    const int bid = opaque_bid();
    for (int it = bid; it < NADA; it += G) adaln_item(p, it, lds);
    transpose_list(p, lds, 0, 3264, bid, G);
}
__device__ __forceinline__ void deferred_weights(const Params& p, LAS unsigned char* lds8, int list, int nunits) {
    const int G = gridDim.x, rem = nunits % G, c = opaque_bid();
    if (rem == 0) transpose_list(p, (LAS float*)lds8, list, 2112, c, G);
    else if (c >= rem) transpose_list(p, (LAS float*)lds8, list, 2112, c - rem, G - rem);
}

__device__ __forceinline__ void store_bf16x8(bf16_t* dst, const f32x4 a, const f32x4 b) {
    u32x4 w; w.x = cvt_pk_bf16(a[0], a[1]); w.y = cvt_pk_bf16(a[2], a[3]); w.z = cvt_pk_bf16(b[0], b[1]); w.w = cvt_pk_bf16(b[2], b[3]);
    *(u32x4*)dst = w;
}

__device__ __forceinline__ void phase_prep0(const Params& p) {
    const int tid_ = opaque_tid(), bid_ = opaque_bid(); const int wid = tid_ >> 6, lane = tid_ & 63;
    const float* mod = (const float*)(p.ws + WS_MOD);
    bf16_t* P = (bf16_t*)(p.ws + WS_P);
    for (int g4 = bid_ * 8 + wid; g4 < NTOK / 4; g4 += gridDim.x * 8) {
        const int row0 = g4 * 4; const int cnd = cond_of_row(row0);
        const float* src = row0 < NCTX ? p.in[0] + (size_t)row0 * D : p.in[1] + (size_t)(row0 - NCTX) * D;
        const float* sh = mod + (0 * 5 + cnd) * 6144, *sc = sh + 1024;
        f32x4 x[4][2][2];
#pragma unroll
        for (int r = 0; r < 4; ++r)
#pragma unroll
            for (int j = 0; j < 2; ++j) { const int col = j * 512 + lane * 8; x[r][j][0] = *(const f32x4*)(src + r * D + col); x[r][j][1] = *(const f32x4*)(src + r * D + col + 4); }
#pragma unroll
        for (int j = 0; j < 2; ++j) { const int col = j * 512 + lane * 8;
            const f32x4 s0 = 1.0f + *(const f32x4*)(sc + col), s1 = 1.0f + *(const f32x4*)(sc + col + 4), b0 = *(const f32x4*)(sh + col), b1 = *(const f32x4*)(sh + col + 4);
#pragma unroll
            for (int r = 0; r < 4; ++r) store_bf16x8(P + (size_t)(row0 + r) * D + col, x[r][j][0] * s0 + b0, x[r][j][1] * s1 + b1); }
    }
}

__device__ __forceinline__ void phase_ln(const Params& p, int layer, int which, int npart, bool wrP) {
    const int tid_ = opaque_tid(), bid_ = opaque_bid(); const int wid = tid_ >> 6, lane = tid_ & 63;
    const float* mod = (const float*)(p.ws + WS_MOD);
    const float* Z = (const float*)(p.ws + WS_Z);
    const f32x2* ST = (const f32x2*)(p.ws + WS_ST);
    float* X = p.out;
    const float* lg = p.in[8] + (layer * 2 + which) * 1024, *lb = p.in[9] + (layer * 2 + which) * 1024;
    for (int g4 = bid_ * 8 + wid; g4 < NTOK / 4; g4 += gridDim.x * 8) {
        const int row0 = g4 * 4;
        f32x2 st[4]; f32x4 z[4][2][2];
#pragma unroll
        for (int r = 0; r < 4; ++r) { st[r] = lane < npart ? ST[(size_t)(row0 + r) * 32 + lane] : (f32x2){0.f, 0.f};
#pragma unroll
            for (int j = 0; j < 2; ++j) { const size_t off = (size_t)(row0 + r) * D + j * 512 + lane * 8; z[r][j][0] = *(const f32x4*)(Z + off); z[r][j][1] = *(const f32x4*)(Z + off + 4); } }
        float mean[4], rstd[4];
#pragma unroll
        for (int r = 0; r < 4; ++r) {
#pragma unroll
            for (int o = 1; o < 64; o <<= 1) { st[r].x += __shfl_xor(st[r].x, o); st[r].y += __shfl_xor(st[r].y, o); }
            mean[r] = st[r].x * (1.0f / 1024.0f); const float var = fmaxf(st[r].y * (1.0f / 1024.0f) - mean[r] * mean[r], 0.f); rstd[r] = rsqrtf(var + LN_EPS); }
        const int cnd = cond_of_row(row0);
        const float* sh = nullptr; const float* sc = nullptr; bf16_t* dst = nullptr;
        if (which == 0) { sh = mod + (layer * 5 + cnd) * 6144 + 3 * 1024; sc = sh + 1024; dst = (bf16_t*)(p.ws + WS_Q); }
        else if (wrP) { sh = mod + ((layer + 1) * 5 + cnd) * 6144; sc = sh + 1024; dst = (bf16_t*)(p.ws + WS_P); }
#pragma unroll
        for (int j = 0; j < 2; ++j) { const int col = j * 512 + lane * 8;
            const f32x4 g0 = *(const f32x4*)(lg + col), g1 = *(const f32x4*)(lg + col + 4), b0 = *(const f32x4*)(lb + col), b1 = *(const f32x4*)(lb + col + 4);
            f32x4 s0 = {0.f, 0.f, 0.f, 0.f}, s1 = s0, h0 = s0, h1 = s0;
            if (dst) { s0 = 1.0f + *(const f32x4*)(sc + col); s1 = 1.0f + *(const f32x4*)(sc + col + 4); h0 = *(const f32x4*)(sh + col); h1 = *(const f32x4*)(sh + col + 4); }
#pragma unroll
            for (int r = 0; r < 4; ++r) { const size_t off = (size_t)(row0 + r) * D + col;
                const f32x4 x0 = (z[r][j][0] - mean[r]) * rstd[r] * g0 + b0, x1 = (z[r][j][1] - mean[r]) * rstd[r] * g1 + b1;
                *(f32x4*)(X + off) = x0; *(f32x4*)(X + off + 4) = x1;
                if (dst) store_bf16x8(dst + off, x0 * s0 + h0, x1 * s1 + h1); } }
    }
}

__device__ __forceinline__ void phase_comb(const Params& p, int jj) {
    const int tid_ = opaque_tid(), bid_ = opaque_bid(); const int wid = tid_ >> 6, lane = tid_ & 63;
    const bf16_t* P = (const bf16_t*)(p.ws + WS_P);
    const float* YF = (const float*)(p.ws + WS_Y), *YB = YF + (size_t)NTOK * D;
    bf16_t* Q = (bf16_t*)(p.ws + WS_Q);
    const float* dsk = p.in[17] + jj * 1024;
    for (int g2 = bid_ * 8 + wid; g2 < NTOK / 2; g2 += gridDim.x * 8) {
        const int row0 = g2 * 2;
        u32x4 uw[2][2]; f32x4 yf[2][2][2], yb[2][2][2];
#pragma unroll
        for (int r = 0; r < 2; ++r)
#pragma unroll
            for (int j = 0; j < 2; ++j) { const size_t off = (size_t)(row0 + r) * D + j * 512 + lane * 8;
                uw[r][j] = *(const u32x4*)(P + off); yf[r][j][0] = *(const f32x4*)(YF + off); yf[r][j][1] = *(const f32x4*)(YF + off + 4); yb[r][j][0] = *(const f32x4*)(YB + off); yb[r][j][1] = *(const f32x4*)(YB + off + 4); }
#pragma unroll
        for (int j = 0; j < 2; ++j) { const int col = j * 512 + lane * 8; const f32x4 d0 = *(const f32x4*)(dsk + col), d1 = *(const f32x4*)(dsk + col + 4);
#pragma unroll
            for (int r = 0; r < 2; ++r) { const u32x4 w = uw[r][j];
                const f32x4 u0 = {bf_lo(w.x), bf_hi(w.x), bf_lo(w.y), bf_hi(w.y)}, u1 = {bf_lo(w.z), bf_hi(w.z), bf_lo(w.w), bf_hi(w.w)};
                f32x4 y0 = u0 * d0 + yf[r][j][0] + yb[r][j][0], y1 = u1 * d1 + yf[r][j][1] + yb[r][j][1];
#pragma unroll
                for (int e = 0; e < 4; ++e) { y0[e] = gelu_tanh(y0[e]); y1[e] = gelu_tanh(y1[e]); }
                store_bf16x8(Q + (size_t)(row0 + r) * D + col, y0, y1); } }
    }
}

template <int K> __device__ __forceinline__ void pool2d_task(const float* X, const float* mod, bf16_t* Q, int layer, int b, int c, int ch) {
    const int clo = max(c - K / 2, 0), chi = min(c - K / 2 + K, 64);
    const size_t tb = (size_t)(NCTX + b * 2048);
    f32x2 hs[32];
#pragma unroll
    for (int r = 0; r < 32; ++r) hs[r] = (f32x2){0.f, 0.f};
    for (int cc = clo; cc < chi; ++cc) {
        const float* xp = X + (tb + cc) * D + ch;
#pragma unroll
        for (int rh = 0; rh < 2; ++rh) {
            f32x2 t_[16];
#pragma unroll
            for (int r = 0; r < 16; ++r) t_[r] = *(const f32x2*)(xp + (size_t)(rh * 16 + r) * 64 * D);
#pragma unroll
            for (int r = 0; r < 16; ++r) hs[rh * 16 + r] += t_[r]; } }
    const f32x2 sc = *(const f32x2*)(mod + (layer * 5 + 1 + b) * 6144 + 1024 + ch);
#pragma unroll
    for (int r = 0; r < 32; ++r) { const int rlo = (r - K / 2) < 0 ? 0 : (r - K / 2), rhi = (r - K / 2 + K) > 32 ? 32 : (r - K / 2 + K);
        f32x2 t = {0.f, 0.f};
#pragma unroll
        for (int rr = rlo; rr < rhi; ++rr) t += hs[rr];
        const float inv = 1.0f / (float)((rhi - rlo) * (chi - clo));
        const size_t off = (tb + r * 64 + c) * D + ch;
        const f32x2 xc = *(const f32x2*)(X + off);
        const f32x2 o = (t * inv - xc) * (1.0f + sc);
        *(unsigned*)(Q + off) = cvt_pk_bf16(o.x, o.y); }
}
template <int K> __device__ __forceinline__ void pool1d_task(const float* X, const float* mod, bf16_t* Q, int layer, int b, int t0, int ch) {
    const size_t tb = (size_t)b * 256;
    f32x2 v[16 + K];
#pragma unroll
    for (int i = 0; i < 16 + K; ++i) { const int t = t0 - K / 2 + i; v[i] = (t >= 0 && t < 256) ? *(const f32x2*)(X + (tb + t) * D + ch) : (f32x2){0.f, 0.f}; }
    const f32x2 sc = *(const f32x2*)(mod + (layer * 5 + 0) * 6144 + 1024 + ch);
#pragma unroll
    for (int i = 0; i < 16; ++i) { const int t = t0 + i; const int lo = max(t - K / 2, 0), hi = min(t - K / 2 + K, 256);
        f32x2 s = {0.f, 0.f};
#pragma unroll
        for (int k2 = 0; k2 < K; ++k2) s += v[i + k2];
        const float inv = 1.0f / (float)(hi - lo);
        const f32x2 o = (s * inv - v[i + K / 2]) * (1.0f + sc);
        *(unsigned*)(Q + (tb + t) * D + ch) = cvt_pk_bf16(o.x, o.y); }
}
__device__ __forceinline__ void phase_poolprep(const Params& p, int layer) {
    const int tid_ = opaque_tid(), bid_ = opaque_bid(); const int wid = tid_ >> 6, lane = tid_ & 63;
    const float* X = p.out; const float* mod = (const float*)(p.ws + WS_MOD); bf16_t* Q = (bf16_t*)(p.ws + WS_Q);
    const int nslots = gridDim.x * 8;
    for (int t = wid * gridDim.x + bid_; t < 2048 + 4096; t += nslots) {
        if (t < 2048) { const int gi = 3 - (t >> 9), r = t & 511, b = r >> 7, c = (r >> 1) & 63, half = r & 1; const int ch = gi * 256 + half * 128 + lane * 2;
            if (gi == 3) pool2d_task<16>(X, mod, Q, layer, b, c, ch); else if (gi == 2) pool2d_task<8>(X, mod, Q, layer, b, c, ch);
            else if (gi == 1) pool2d_task<4>(X, mod, Q, layer, b, c, ch); else pool2d_task<2>(X, mod, Q, layer, b, c, ch);
        } else { const int u = t - 2048; const int gi = 3 - (u >> 10), r = u & 1023, b = r >> 5, seg = (r >> 1) & 15, half = r & 1; const int ch = gi * 256 + half * 128 + lane * 2;
            if (gi == 3) pool1d_task<16>(X, mod, Q, layer, b, seg * 16, ch); else if (gi == 2) pool1d_task<8>(X, mod, Q, layer, b, seg * 16, ch);
            else if (gi == 1) pool1d_task<4>(X, mod, Q, layer, b, seg * 16, ch); else pool1d_task<2>(X, mod, Q, layer, b, seg * 16, ch);
        }
    }
}

constexpr int S5_ROWB = 272;
constexpr int S5_WAVE_LDS = 32 * S5_ROWB;

template <int MODE>
__device__ __forceinline__ void s5_task(const Params& p, int jj, int task, LAS unsigned char* wl, int lane) {
    const int pair = task >> 7, dir = (task >> 6) & 1, g = task & 63;
    constexpr int L = 256, ntile = 16;
    const int half = lane >> 5, p0 = lane & 31;
    const int pidx = (jj * 2 + dir) * 64 + g;
    const float dt = expf(p.in[12][pidx]);
    float ar[2], ai[2]; bf16x8 Bre[2], Bim[2];
#pragma unroll
    for (int s = 0; s < 2; ++s) { const int P = p0 + 32 * s;
        const float are = p.in[10][pidx * 64 + P], aim = p.in[11][pidx * 64 + P];
        const float mag = expf(are * dt), ang = aim * dt; float sn, cs; sn = sinf(ang); cs = cosf(ang);
        const float abr = mag * cs, abi = mag * sn, den = are * are + aim * aim, nr = abr - 1.0f;
        const float cr = (nr * are + abi * aim) / den, ci = (abi * are - nr * aim) / den;
        const float* br = p.in[13] + ((size_t)(pidx * 64 + P) * 16 + half * 8), *bi = p.in[14] + ((size_t)(pidx * 64 + P) * 16 + half * 8);
        const f32x4 br0 = *(const f32x4*)br, br1 = *(const f32x4*)(br + 4), bi0 = *(const f32x4*)bi, bi1 = *(const f32x4*)(bi + 4);
        const f32x4 r0 = cr * br0 - ci * bi0, r1 = cr * br1 - ci * bi1, i0 = cr * bi0 + ci * br0, i1 = cr * bi1 + ci * br1;
        u32x4 wr_, wi_;
        wr_.x = cvt_pk_bf16(r0[0], r0[1]); wr_.y = cvt_pk_bf16(r0[2], r0[3]); wr_.z = cvt_pk_bf16(r1[0], r1[1]); wr_.w = cvt_pk_bf16(r1[2], r1[3]);
        wi_.x = cvt_pk_bf16(i0[0], i0[1]); wi_.y = cvt_pk_bf16(i0[2], i0[3]); wi_.z = cvt_pk_bf16(i1[0], i1[1]); wi_.w = cvt_pk_bf16(i1[2], i1[3]);
        Bre[s] = __builtin_bit_cast(bf16x8, wr_); Bim[s] = __builtin_bit_cast(bf16x8, wi_);
        ar[s] = abr; ai[s] = abi; }
    const int csc = pair * 2 + half;
    f32x2* E = (f32x2*)(p.ws + WS_E);
    float sr[2], si[2];
#pragma unroll
    for (int s = 0; s < 2; ++s) { sr[s] = 0.f; si[s] = 0.f; }
    if (MODE == 2) {
        const int b = csc >> 3, k = csc & 7;
#pragma unroll
        for (int s = 0; s < 2; ++s) { const int P = p0 + 32 * s;
            float qr = ar[s], qi = ai[s];
#pragma unroll
            for (int e = 0; e < 8; ++e) { const float t = qr * qr - qi * qi; qi = 2.0f * qr * qi; qr = t; }
            const size_t ix = ((size_t)((b * 2 + jj) * 2 + dir) * 64 + g) * 64 + P;
            float hr = p.in[2][ix], hi = p.in[3][ix];
            for (int e = 0; e < 7; ++e) { const int kk = dir ? 7 - e : e;
                const bool pre = dir ? (kk > k) : (kk < k);
                const f32x2 ev = E[((size_t)((b * 8 + kk) * 2 + dir) * 64 + g) * 64 + P];
                if (pre) { const float t = qr * hr - qi * hi + ev.x; hi = qr * hi + qi * hr + ev.y; hr = t; } }
            sr[s] = hr; si[s] = hi; }
    }
    bf16x8 Cop[4];
    if (MODE != 1) { const int n = lane & 15, kq = lane >> 4;
#pragma unroll
      for (int ks = 0; ks < 4; ++ks) { const int pp = ks * 16 + kq * 4;
          const f32x4 cre = *(const f32x4*)(p.in[15] + ((size_t)(pidx * 16 + n) * 64 + pp)), cim = *(const f32x4*)(p.in[16] + ((size_t)(pidx * 16 + n) * 64 + pp));
          u32x4 w; w.x = cvt_pk_bf16(cre[0], -cim[0]); w.y = cvt_pk_bf16(cre[1], -cim[1]); w.z = cvt_pk_bf16(cre[2], -cim[2]); w.w = cvt_pk_bf16(cre[3], -cim[3]);
          Cop[ks] = __builtin_bit_cast(bf16x8, w); } }
    const int m = lane & 31, lc = (m >> 2) & 1, ltau = ((m >> 3) << 2) | (m & 3), kh = lane >> 5;
    const int lch = pair * 2 + lc; const int lbase = MODE == 0 ? lch * 256 : NCTX + lch * 256;
    const bf16_t* Pu = (const bf16_t*)(p.ws + WS_P) + g * 16 + kh * 8;
    float* Yd = (float*)(p.ws + WS_Y) + (size_t)dir * NTOK * D + g * 16 + (lane >> 4) * 4;
    const int otau = lane & 15;
    auto tok_of = [&](int base, int ti, int tau) { const int step = ti * 16 + tau; return base + (dir ? (L - 1 - step) : step); };
    bf16x8 u0 = *(const bf16x8*)(Pu + (size_t)tok_of(lbase, 0, ltau) * D);
    bf16x8 u1 = *(const bf16x8*)(Pu + (size_t)tok_of(lbase, 1, ltau) * D);
    const f32x16 zero16 = {0.f, 0.f, 0.f, 0.f, 0.f, 0.f, 0.f, 0.f, 0.f, 0.f, 0.f, 0.f, 0.f, 0.f, 0.f, 0.f};
    for (int ti = 0; ti < ntile; ++ti) {
        const int tn = min(ti + 2, ntile - 1);
        const bf16x8 u2 = *(const bf16x8*)(Pu + (size_t)tok_of(lbase, tn, ltau) * D);
        f32x16 dre[2], dim_[2];
        asm volatile("s_nop 4\n\t"
                     "v_mfma_f32_32x32x16_bf16 %0, %4, %5, 0\n\t"
                     "v_mfma_f32_32x32x16_bf16 %1, %4, %6, 0\n\t"
                     "v_mfma_f32_32x32x16_bf16 %2, %4, %7, 0\n\t"
                     "v_mfma_f32_32x32x16_bf16 %3, %4, %8, 0\n\t"
                     "s_nop 15\n\ts_nop 15\n\ts_nop 7"
                     : "=&v"(dre[0]), "=&v"(dim_[0]), "=&v"(dre[1]), "=&v"(dim_[1])
                     : "v"(u0), "v"(Bre[0]), "v"(Bim[0]), "v"(Bre[1]), "v"(Bim[1]));
        float x0r = sr[0], x0i = si[0], x1r = sr[1], x1i = si[1];
#pragma unroll
        for (int i = 0; i < 16; ++i) {
            const float n0r = fmaf(ar[0], x0r, fmaf(-ai[0], x0i, dre[0][i])), n0i = fmaf(ar[0], x0i, fmaf(ai[0], x0r, dim_[0][i]));
            const float n1r = fmaf(ar[1], x1r, fmaf(-ai[1], x1i, dre[1][i])), n1i = fmaf(ar[1], x1i, fmaf(ai[1], x1r, dim_[1][i]));
            x0r = n0r; x0i = n0i; x1r = n1r; x1i = n1i;
            if (MODE != 1) { *(LAS unsigned*)(wl + (half * 16 + i) * S5_ROWB + p0 * 4) = cvt_pk_bf16(x0r, x0i);
                             *(LAS unsigned*)(wl + (half * 16 + i) * S5_ROWB + (p0 + 32) * 4) = cvt_pk_bf16(x1r, x1i); }
        }
        sr[0] = x0r; si[0] = x0i; sr[1] = x1r; si[1] = x1i;
        if (MODE != 1) {
            asm volatile("s_waitcnt lgkmcnt(0)" ::: "memory");
            __builtin_amdgcn_wave_barrier();
#pragma unroll
            for (int c = 0; c < 2; ++c) { f32x4 acc = {0.f, 0.f, 0.f, 0.f};
#pragma unroll
                for (int ks = 0; ks < 4; ++ks) { const bf16x8 sf = *(const LAS bf16x8*)(wl + (c * 16 + otau) * S5_ROWB + ks * 64 + (lane >> 4) * 16);
                    acc = __builtin_amdgcn_mfma_f32_16x16x32_bf16(Cop[ks], sf, acc, 0, 0, 0); }
                const int och = pair * 2 + c; const int obase = MODE == 0 ? och * 256 : NCTX + och * 256;
                *(f32x4*)(Yd + (size_t)tok_of(obase, ti, otau) * D) = acc; }
            asm volatile("s_waitcnt lgkmcnt(0)" ::: "memory");
            __builtin_amdgcn_wave_barrier();
        }
        u0 = u1; u1 = u2;
    }
    if (MODE == 0) { float* ore = p.out + (size_t)NTOK * D, *oim = ore + 32 * 2 * 2 * 64 * 64;
#pragma unroll
        for (int s = 0; s < 2; ++s) { const size_t ix = ((size_t)((csc * 2 + jj) * 2 + dir) * 64 + g) * 64 + p0 + 32 * s; ore[ix] = sr[s]; oim[ix] = si[s]; } }
    if (MODE == 1) {
#pragma unroll
        for (int s = 0; s < 2; ++s) E[((size_t)(csc * 2 + dir) * 64 + g) * 64 + p0 + 32 * s] = (f32x2){sr[s], si[s]}; }
}

__device__ __forceinline__ void s5_combine(const Params& p, int jj, bool lat, int idx, int c, int lane) {
    const int pair = idx >> 6, g = idx & 63, seq = pair * 2 + c; const int base = lat ? NCTX + seq * 256 : seq * 256;
    const bf16_t* P = (const bf16_t*)(p.ws + WS_P);
    const float* YF = (const float*)(p.ws + WS_Y), *YB = YF + (size_t)NTOK * D;
    bf16_t* Q = (bf16_t*)(p.ws + WS_Q);
    const float* dsk = p.in[17] + jj * 1024 + g * 16;
    const f32x4 d0 = *(const f32x4*)dsk, d1 = *(const f32x4*)(dsk + 4), d2 = *(const f32x4*)(dsk + 8), d3 = *(const f32x4*)(dsk + 12);
#pragma unroll
    for (int jp = 0; jp < 2; ++jp) {
        u32x4 uw[2][2]; f32x4 yf[2][4], yb[2][4];
#pragma unroll
        for (int r = 0; r < 2; ++r) { const size_t off = (size_t)(base + lane + 64 * (jp * 2 + r)) * D + g * 16;
            uw[r][0] = *(const u32x4*)(P + off); uw[r][1] = *(const u32x4*)(P + off + 8);
#pragma unroll
            for (int e = 0; e < 4; ++e) { yf[r][e] = *(const f32x4*)(YF + off + 4 * e); yb[r][e] = *(const f32x4*)(YB + off + 4 * e); } }
#pragma unroll
        for (int r = 0; r < 2; ++r) { const size_t off = (size_t)(base + lane + 64 * (jp * 2 + r)) * D + g * 16;
            const u32x4 w0 = uw[r][0], w1 = uw[r][1];
            f32x4 y0 = (f32x4){bf_lo(w0.x), bf_hi(w0.x), bf_lo(w0.y), bf_hi(w0.y)} * d0 + yf[r][0] + yb[r][0];
            f32x4 y1 = (f32x4){bf_lo(w0.z), bf_hi(w0.z), bf_lo(w0.w), bf_hi(w0.w)} * d1 + yf[r][1] + yb[r][1];
            f32x4 y2 = (f32x4){bf_lo(w1.x), bf_hi(w1.x), bf_lo(w1.y), bf_hi(w1.y)} * d2 + yf[r][2] + yb[r][2];
            f32x4 y3 = (f32x4){bf_lo(w1.z), bf_hi(w1.z), bf_lo(w1.w), bf_hi(w1.w)} * d3 + yf[r][3] + yb[r][3];
#pragma unroll
            for (int e = 0; e < 4; ++e) { y0[e] = gelu_tanh(y0[e]); y1[e] = gelu_tanh(y1[e]); y2[e] = gelu_tanh(y2[e]); y3[e] = gelu_tanh(y3[e]); }
            store_bf16x8(Q + off, y0, y1); store_bf16x8(Q + off + 8, y2, y3); }
    }
}

__device__ __forceinline__ void phase_s5(const Params& p, int jj, int sub, LAS unsigned char* lds) {
    const int tid_ = opaque_tid(), bid_ = opaque_bid(); const int wid = tid_ >> 6, lane = tid_ & 63;
    const int G = gridDim.x, nslots = G * 8, slot = wid * G + bid_;
    LAS unsigned char* wl = lds + wid * S5_WAVE_LDS;
    if (sub == 0) { for (int t = slot; t < 2048; t += nslots) s5_task<1>(p, jj, t, wl, lane); }
    for (int b4 = bid_; b4 < 256; b4 += G) {
        const int idx = b4 * 4 + (wid >> 1); const int task = ((idx >> 6) << 7) | ((wid & 1) << 6) | (idx & 63);
        if (sub == 0) s5_task<0>(p, jj, task, wl, lane); else s5_task<2>(p, jj, task, wl, lane);
        __syncthreads();
        s5_combine(p, jj, sub != 0, idx, wid & 1, lane);
    }
}

namespace pg8 {
constexpr int BM = 256, BK = 64, HALF = 128, HTB = HALF * BK * 2, NXCD = 8, WGM = 8;
__device__ __forceinline__ int lds_byte(int r, int c) { const int st = (r >> 4) * 2 + (c >> 5), rr = r & 15, cc = c & 31, ob = rr * 64 + cc * 2; return st * 1024 + (ob ^ (((ob >> 9) & 1) << 5)); }
__device__ __forceinline__ void stage_rc(int b, int& R, int& C) { const int st = b / 1024, sb = b % 1024, swz = sb ^ (((sb >> 9) & 1) << 5); R = (st >> 1) * 16 + swz / 64; C = (st & 1) * 32 + (swz % 64) / 2; }
struct Unit { int pm, pn; };
struct Gemm { const bf16_t* A; const bf16_t* Bt; int M, N, K, lda, acol; };
struct StaticOrder {
    int nM, nN, nwg, G, c;
    __device__ void init(int M, int N, int G_, int c_) { nM = M / BM; nN = N / BM; nwg = nM * nN; G = G_; c = c_; }
    __device__ bool next(int i, Unit& u) const {
        const long L = (long)i * G + c; if (L >= nwg) return false;
        int wgid = (int)L; { const int q = nwg / NXCD, r = nwg % NXCD, xcd = wgid % NXCD, off = wgid / NXCD; wgid = (xcd < r ? xcd * (q + 1) : r * (q + 1) + (xcd - r) * q) + off; }
        const int nig = WGM * nN, gid = wgid / nig, fm = gid * WGM, gsz = (nM - fm) < WGM ? (nM - fm) : WGM;
        u.pm = fm + ((wgid % nig) % gsz); u.pn = (wgid % nig) / gsz; return true;
    }
};

template <class Epi>
__device__ __forceinline__ void gemm_phase(LAS unsigned char* lds, const Gemm g, const StaticOrder& S, const Epi& E) {
    const int tid = opaque_tid(), wid = __builtin_amdgcn_readfirstlane(tid >> 6), lane = tid & 63, wr = wid >> 2, wc = wid & 3, fr = lane & 15, fq = lane >> 4;
    const int K = g.K, nt = K / BK, lda = g.lda;
    unsigned voffA[2], voffB[2];
#pragma unroll
    for (int i = 0; i < 2; ++i) { int R, C; stage_rc(tid * 16 + i * 8192, R, C); voffA[i] = (unsigned)(R * lda + C) * 2u; voffB[i] = (unsigned)(R * K + C) * 2u; }
    const size_t kstep = (size_t)(BK * 2);
    const size_t hstepA = (size_t)HALF * lda * 2, hstepB = (size_t)HALF * K * 2;
    const size_t tstepA = 2 * hstepA, tstepB = 2 * hstepB;
    const size_t acolb = (size_t)g.acol * 2;
    const unsigned ldsw = (unsigned)wid * 1024u;
    const int aoff = lds_byte(wr * 64 + fr, fq * 8), boff = lds_byte(wc * 32 + fr, fq * 8);
#define PG8_SA(b, h) (((b) * 2 + (h)) * HTB)
#define PG8_SB(b, h) ((4 + (b) * 2 + (h)) * HTB)
#define PG8_STAGE(bufoff, gbase, voff) do { _Pragma("unroll") for (int _i = 0; _i < 2; ++_i) \
        __builtin_amdgcn_global_load_lds((const unsigned*)((const char*)(gbase) + (voff)[_i]), (LAS unsigned*)(lds + (bufoff) + ldsw + _i * 8192), 16, 0, 0); } while (0)
#define PG8_LDA(dst, b, h) do { _Pragma("unroll") for (int m = 0; m < 4; ++m) _Pragma("unroll") for (int k = 0; k < 2; ++k) dst[m][k] = *(const LAS bf16x8*)(lds + PG8_SA(b, h) + aoff + m * 2048 + k * 1024); } while (0)
#define PG8_LDB(dst, b, h) do { _Pragma("unroll") for (int n = 0; n < 2; ++n) _Pragma("unroll") for (int k = 0; k < 2; ++k) dst[n][k] = *(const LAS bf16x8*)(lds + PG8_SB(b, h) + boff + n * 2048 + k * 1024); } while (0)
#define PG8_MMA(ai, bj, At, Bt) do { __builtin_amdgcn_s_setprio(1); _Pragma("unroll") for (int m = 0; m < 4; ++m) _Pragma("unroll") for (int n = 0; n < 2; ++n) _Pragma("unroll") for (int k = 0; k < 2; ++k) \
        acc[ai][bj][m][n] = __builtin_amdgcn_mfma_f32_16x16x32_bf16(Bt[n][k], At[m][k], acc[ai][bj][m][n], 0, 0, 0); __builtin_amdgcn_s_setprio(0); } while (0)
#define PG8_WAIT_V(n) asm volatile("s_waitcnt vmcnt(" #n ")" ::: "memory")
#define PG8_WAIT_L(n) asm volatile("s_waitcnt lgkmcnt(" #n ")" ::: "memory")
#define PG8_BAR __builtin_amdgcn_s_barrier()
#define PG8_SCHED __builtin_amdgcn_sched_barrier(0)
    Unit cur, nxt; int ui = 0;
    if (!S.next(0, cur)) return;
    f32x4 acc[2][2][4][2];
#pragma unroll
    for (int a = 0; a < 2; ++a)
#pragma unroll
        for (int b = 0; b < 2; ++b)
#pragma unroll
            for (int m = 0; m < 4; ++m)
#pragma unroll
                for (int n = 0; n < 2; ++n) acc[a][b][m][n] = (f32x4){0.f, 0.f, 0.f, 0.f};
    bf16x8 At[4][2], B0[2][2], B1[2][2];
    const char* cA = (const char*)g.A + (size_t)cur.pm * tstepA + (size_t)cur.pn * acolb; const char* cB = (const char*)g.Bt + (size_t)cur.pn * tstepB;
    PG8_STAGE(PG8_SB(0, 0), cB, voffB); PG8_STAGE(PG8_SA(0, 0), cA, voffA); PG8_STAGE(PG8_SB(0, 1), cB + hstepB, voffB); PG8_STAGE(PG8_SA(0, 1), cA + hstepA, voffA);
    if (wr == 1) PG8_BAR;
    PG8_WAIT_V(4); PG8_BAR;
    PG8_STAGE(PG8_SB(1, 0), cB + kstep, voffB); PG8_STAGE(PG8_SA(1, 0), cA + kstep, voffA); PG8_STAGE(PG8_SB(1, 1), cB + hstepB + kstep, voffB);
    PG8_WAIT_V(6); PG8_BAR;
    for (;;) {
        const bool has_next = S.next(ui + 1, nxt);
        const char* nA = has_next ? (const char*)g.A + (size_t)nxt.pm * tstepA + (size_t)nxt.pn * acolb : cA; const char* nB = has_next ? (const char*)g.Bt + (size_t)nxt.pn * tstepB : cB;
        for (int t = 0; t < nt; t += 2) {
            const bool last = (t == nt - 2);
            const char* a1 = cA + (size_t)(t + 1) * kstep;
            const char* a2 = last ? nA : cA + (size_t)(t + 2) * kstep; const char* b2 = last ? nB : cB + (size_t)(t + 2) * kstep;
            const char* a3 = a2 + kstep; const char* b3 = b2 + kstep;
            PG8_LDB(B0, 0, 0); PG8_SCHED; PG8_LDA(At, 0, 0); PG8_STAGE(PG8_SA(1, 1), a1 + hstepA, voffA);
            PG8_WAIT_L(8); PG8_BAR; PG8_WAIT_L(0); PG8_MMA(0, 0, At, B0); PG8_BAR; PG8_SCHED;
            PG8_LDB(B1, 0, 1); PG8_STAGE(PG8_SB(0, 0), b2, voffB);
            PG8_BAR; PG8_WAIT_L(0); PG8_MMA(0, 1, At, B1); PG8_BAR;
            PG8_LDA(At, 0, 1); PG8_STAGE(PG8_SA(0, 0), a2, voffA);
            PG8_BAR; PG8_WAIT_L(0); PG8_MMA(1, 0, At, B0); PG8_BAR; PG8_SCHED;
            PG8_STAGE(PG8_SB(0, 1), b2 + hstepB, voffB);
            PG8_WAIT_V(6); PG8_BAR; PG8_MMA(1, 1, At, B1); PG8_BAR;
            PG8_LDB(B0, 1, 0); PG8_SCHED; PG8_LDA(At, 1, 0); PG8_STAGE(PG8_SA(0, 1), a2 + hstepA, voffA);
            PG8_WAIT_L(8); PG8_BAR; PG8_WAIT_L(0); PG8_MMA(0, 0, At, B0); PG8_BAR; PG8_SCHED;
            PG8_LDB(B1, 1, 1); PG8_STAGE(PG8_SB(1, 0), b3, voffB);
            PG8_BAR; PG8_WAIT_L(0); PG8_MMA(0, 1, At, B1); PG8_BAR;
            PG8_LDA(At, 1, 1); PG8_STAGE(PG8_SA(1, 0), a3, voffA);
            PG8_BAR; PG8_WAIT_L(0); PG8_MMA(1, 0, At, B0); PG8_BAR; PG8_SCHED;
            PG8_STAGE(PG8_SB(1, 1), b3 + hstepB, voffB);
            PG8_WAIT_V(6); PG8_BAR; PG8_MMA(1, 1, At, B1); PG8_BAR;
        }
        E(acc, cur, wr, wc, fr, fq);
        if (!has_next) break;
#pragma unroll
        for (int a = 0; a < 2; ++a)
#pragma unroll
            for (int b = 0; b < 2; ++b)
#pragma unroll
                for (int m = 0; m < 4; ++m)
#pragma unroll
                    for (int n = 0; n < 2; ++n) acc[a][b][m][n] = (f32x4){0.f, 0.f, 0.f, 0.f};
        cur = nxt; cA = nA; cB = nB; ++ui;
    }
    PG8_WAIT_V(0);
    if (wr == 0) PG8_BAR;
    PG8_BAR;
#undef PG8_SA
#undef PG8_SB
#undef PG8_STAGE
#undef PG8_LDA
#undef PG8_LDB
#undef PG8_MMA
#undef PG8_WAIT_V
#undef PG8_WAIT_L
#undef PG8_BAR
#undef PG8_SCHED
}
}

__device__ __forceinline__ void stat_store(float s, float q, f32x2* ST, int row, int part, int fq) {
    s += __shfl_xor(s, 16); s += __shfl_xor(s, 32); q += __shfl_xor(q, 16); q += __shfl_xor(q, 32);
    if (fq == 0) ST[(size_t)row * 32 + part] = (f32x2){s, q};
}
struct EpiGlu {
    const float* bias; const float* xlo; const float* xhi; const float* mod; float* Z; f32x2* ST;
    __device__ __forceinline__ void operator()(const f32x4 (&acc)[2][2][4][2], const pg8::Unit& u, int wr, int wc, int fr, int fq) const {
        const int cnd = u.pm < 32 ? 0 : 1 + ((u.pm - 32) >> 3);
        const float* xb = u.pm < 32 ? xlo : xhi; const float* g1 = mod + cnd * 6144 + 2 * 1024;
        int oc[2]; f32x4 bv[2], bg[2], gv[2];
#pragma unroll
        for (int bj = 0; bj < 2; ++bj) { oc[bj] = (u.pn * 8 + bj * 4 + wc) * 16 + 4 * fq; bv[bj] = *(const f32x4*)(bias + oc[bj]); bg[bj] = *(const f32x4*)(bias + 1024 + oc[bj]); gv[bj] = *(const f32x4*)(g1 + oc[bj]); }
#pragma unroll
        for (int ai = 0; ai < 2; ++ai) {
            f32x4 xr[4][2];
#pragma unroll
            for (int m = 0; m < 4; ++m)
#pragma unroll
                for (int bj = 0; bj < 2; ++bj) xr[m][bj] = *(const f32x4*)(xb + (size_t)(u.pm * 256 + ai * 128 + wr * 64 + m * 16 + fr) * D + oc[bj]);
#pragma unroll
            for (int m = 0; m < 4; ++m) { const int row = u.pm * 256 + ai * 128 + wr * 64 + m * 16 + fr; float s = 0.f, q = 0.f;
#pragma unroll
                for (int bj = 0; bj < 2; ++bj) { const f32x4 v = acc[ai][bj][m][0] + bv[bj], gt = acc[ai][bj][m][1] + bg[bj]; f32x4 o;
#pragma unroll
                    for (int e = 0; e < 4; ++e) o[e] = v[e] * sigmoidf_(gt[e]);
                    const f32x4 z = ALPHA * xr[m][bj] + gv[bj] * o;
                    *(f32x4*)(Z + (size_t)row * D + oc[bj]) = z; s += (z[0] + z[1]) + (z[2] + z[3]); q += (z[0] * z[0] + z[1] * z[1]) + (z[2] * z[2] + z[3] * z[3]); }
                stat_store(s, q, ST, row, u.pn * 4 + wc, fq); }
            asm volatile("" ::: "memory"); }
    }
};
struct EpiFfn1 {
    bf16_t* H;
    __device__ __forceinline__ void operator()(const f32x4 (&acc)[2][2][4][2], const pg8::Unit& u, int wr, int wc, int fr, int fq) const {
#pragma unroll
        for (int ai = 0; ai < 2; ++ai)
#pragma unroll
            for (int m = 0; m < 4; ++m) { const int row = u.pm * 256 + ai * 128 + wr * 64 + m * 16 + fr;
#pragma unroll
                for (int bj = 0; bj < 2; ++bj) { const int oc = (u.pn * 8 + bj * 4 + wc) * 16 + 4 * fq; const f32x4 gt = acc[ai][bj][m][0], up = acc[ai][bj][m][1]; f32x4 h;
#pragma unroll
                    for (int e = 0; e < 4; ++e) h[e] = gt[e] * sigmoidf_(gt[e]) * up[e];
                    u32x2 w; w.x = cvt_pk_bf16(h[0], h[1]); w.y = cvt_pk_bf16(h[2], h[3]); *(u32x2*)(H + (size_t)row * DFF + oc) = w; } }
    }
};
struct EpiRes {
    const float* X; const float* mod; int gchunk; const float* scale; float* Z; f32x2* ST;
    __device__ __forceinline__ void operator()(const f32x4 (&acc)[2][2][4][2], const pg8::Unit& u, int wr, int wc, int fr, int fq) const {
        const int cnd = u.pm < 32 ? 0 : 1 + ((u.pm - 32) >> 3);
        const float* gp = mod + cnd * 6144 + gchunk * 1024;
        const int col0 = u.pn * 256 + wc * 32 + 4 * fq;
        f32x4 gv[2][2];
#pragma unroll
        for (int bj = 0; bj < 2; ++bj)
#pragma unroll
            for (int n = 0; n < 2; ++n) { const int col = col0 + bj * 128 + n * 16; gv[bj][n] = *(const f32x4*)(gp + col); if (scale) gv[bj][n] *= *(const f32x4*)(scale + col); }
#pragma unroll
        for (int ai = 0; ai < 2; ++ai)
#pragma unroll
            for (int mh = 0; mh < 2; ++mh) {
                f32x4 xr[2][2][2];
#pragma unroll
                for (int m2 = 0; m2 < 2; ++m2)
#pragma unroll
                    for (int bj = 0; bj < 2; ++bj)
#pragma unroll
                        for (int n = 0; n < 2; ++n) xr[m2][bj][n] = *(const f32x4*)(X + (size_t)(u.pm * 256 + ai * 128 + wr * 64 + (mh * 2 + m2) * 16 + fr) * D + col0 + bj * 128 + n * 16);
#pragma unroll
                for (int m2 = 0; m2 < 2; ++m2) { const int m = mh * 2 + m2; const int row = u.pm * 256 + ai * 128 + wr * 64 + m * 16 + fr; float s = 0.f, q = 0.f;
#pragma unroll
                    for (int bj = 0; bj < 2; ++bj)
#pragma unroll
                        for (int n = 0; n < 2; ++n) { const int col = col0 + bj * 128 + n * 16;
                            const f32x4 z = ALPHA * xr[m2][bj][n] + gv[bj][n] * acc[ai][bj][m][n];
                            *(f32x4*)(Z + (size_t)row * D + col) = z; s += (z[0] + z[1]) + (z[2] + z[3]); q += (z[0] * z[0] + z[1] * z[1]) + (z[2] * z[2] + z[3] * z[3]); }
                    stat_store(s, q, ST, row, u.pn * 4 + wc, fq); }
                asm volatile("" ::: "memory"); }
    }
};

__device__ __forceinline__ void first_seam(const Params& p, LAS unsigned char* lds) {
    volatile LAS unsigned* xst = (volatile LAS unsigned*)(lds + LDS_ST_OFF);
    if (threadIdx.x == 0) { xst[0] = 0u; xst[1] = 0u; }
    __syncthreads();
    (void)xcd_barrier_post((unsigned*)(p.ws + WS_BAR), xst);
}
__device__ __forceinline__ void later_seam(const Params& p, LAS unsigned char* lds) {
    XcdBarrier xb; xb.bar = (unsigned*)(p.ws + WS_BAR); xb.x = xb_xcc_id(); xb.st = (volatile LAS unsigned*)(lds + LDS_ST_OFF);
    xcd_barrier(xb);
}

__global__ void __launch_bounds__(512) mega(Params p) {
    extern __shared__ __attribute__((aligned(16))) unsigned char lds_raw[];
    LAS unsigned char* lds = (LAS unsigned char*)lds_raw;
    cg::grid_group grid = cg::this_grid();
    int ph = 0;
    if (blockIdx.x == 0) for (int i = threadIdx.x; i < XCD_BAR_WORDS; i += 512) ((unsigned*)(p.ws + WS_BAR))[i] = 0u;
#define PHASE_LOCALS const float* mod = (const float*)(p.ws + WS_MOD); float* Z = (float*)(p.ws + WS_Z); f32x2* ST = (f32x2*)(p.ws + WS_ST); bf16_t* Q = (bf16_t*)(p.ws + WS_Q); bf16_t* Hff = (bf16_t*)(p.ws + WS_Y); pg8::StaticOrder S; const float* lmod = mod + layer * 5 * 6144; (void)Z; (void)ST; (void)Q; (void)Hff; (void)lmod; (void)S
#define PHASE(kind, ...) do { if (ph >= p.ph_lo && ph < p.ph_hi) { for (int r_ = 0; r_ <= ((REPMASK >> (kind)) & 1); ++r_) { { const Params& pp_ = p; { Params p = pp_; asm volatile("" : "+s"(p.ws), "+s"(p.out)); PHASE_LOCALS; __VA_ARGS__; } } if (ph + 1 < p.ph_hi || r_ < ((REPMASK >> (kind)) & 1)) { if (ph == p.ph_lo && r_ == 0) { grid.sync(); first_seam(p, lds); } else later_seam(p, lds); } } } ++ph; } while (0)
    { const int layer = 0; (void)layer;
    PHASE(0, phase_w0(p, lds));
    PHASE(1, phase_prep0(p)); }
    for (int layer_ = 0; layer_ < 4; ++layer_) {
        const int layer = opaque_s(layer_);
        const int jj = layer >> 1;
        if ((layer & 1) == 0) {
            PHASE(2, phase_s5(p, jj, 0, lds));
            PHASE(2, phase_s5(p, jj, 1, lds));
            PHASE(4, { pg8::Gemm g{Q, (const bf16_t*)(p.ws + WS_WG) + (size_t)jj * 2048 * 1024, NTOK, 2048, 1024, 1024, 0}; S.init(NTOK, 2048, gridDim.x, opaque_bid());
                    EpiGlu E{p.in[19] + jj * 2048, layer == 0 ? p.in[0] : p.out, layer == 0 ? p.in[1] - (size_t)NCTX * D : p.out, lmod, Z, ST};
                    pg8::gemm_phase(lds, g, S, E); });
            PHASE(5, phase_ln(p, layer, 0, 32, false));
        } else {
            PHASE(6, phase_poolprep(p, layer));
            PHASE(7, { pg8::Gemm g{Q, (const bf16_t*)(p.ws + WS_WP) + (size_t)jj * 4 * 65536, NTOK, 1024, 256, 1024, 256}; S.init(NTOK, 1024, gridDim.x, opaque_bid());
                    EpiRes E{p.out, lmod, 2, p.in[21] + jj * 1024, Z, ST};
                    pg8::gemm_phase(lds, g, S, E); });
            PHASE(5, phase_ln(p, layer, 0, 16, false));
        }
        PHASE(8, { pg8::Gemm g{Q, (const bf16_t*)(p.ws + WS_W1) + (size_t)layer * NFF1 * 1024, NTOK, NFF1, 1024, 1024, 0}; S.init(NTOK, NFF1, gridDim.x, opaque_bid());
                EpiFfn1 E{Hff}; pg8::gemm_phase(lds, g, S, E); if (layer < 3) deferred_weights(p, lds, layer + 1, (NTOK / 256) * (NFF1 / 256)); });
        PHASE(9, { pg8::Gemm g{Hff, (const bf16_t*)(p.ws + WS_W2) + (size_t)layer * 1024 * DFF, NTOK, 1024, DFF, DFF, 0}; S.init(NTOK, 1024, gridDim.x, opaque_bid());
                EpiRes E{p.out, lmod, 5, nullptr, Z, ST}; pg8::gemm_phase(lds, g, S, E); });
        PHASE(10, phase_ln(p, layer, 1, 16, layer == 1));
    }
#undef PHASE
}

extern "C" void kernel_launch(void* const* d_in, const int* in_sizes, int n_in, void* d_out, int out_size, void* d_ws, size_t ws_size, hipStream_t stream) {
    static int grid_blocks = 0;
    if (grid_blocks == 0) {
        if (n_in != 25 || ws_size < WS_END) { fprintf(stderr, "kernel_launch: unexpected n_in %d or ws_size %zu (< %zu)\n", n_in, ws_size, (size_t)WS_END); grid_blocks = -1; return; }
        int dev = 0, cus = 0, per_cu = 0;
        hipGetDevice(&dev);
        hipDeviceGetAttribute(&cus, hipDeviceAttributeMultiprocessorCount, dev);
        if (hipFuncSetAttribute((const void*)mega, hipFuncAttributeMaxDynamicSharedMemorySize, LDS_BYTES) != hipSuccess) { fprintf(stderr, "kernel_launch: hipFuncSetAttribute failed\n"); grid_blocks = -1; return; }
        if (hipOccupancyMaxActiveBlocksPerMultiprocessor(&per_cu, (const void*)mega, 512, LDS_BYTES) != hipSuccess || per_cu < 1) { fprintf(stderr, "kernel_launch: occupancy query failed (%d)\n", per_cu); (void)hipGetLastError(); per_cu = 1; }
        if (per_cu > 1) per_cu = 1;
        grid_blocks = cus * per_cu;
    }
    if (grid_blocks < 0) return;
    Params p{};
    for (int i = 0; i < 25; ++i) p.in[i] = (const float*)d_in[i];
    p.out = (float*)d_out; p.ws = (unsigned char*)d_ws;
#if MULTI_LAUNCH
    for (int ph = 0; ph < NPH; ++ph) { p.ph_lo = ph; p.ph_hi = ph + 1; hipLaunchKernelGGL(mega, dim3(grid_blocks), dim3(512), LDS_BYTES, stream, p); }
#else
    p.ph_lo = 0; p.ph_hi = NPH;
    void* args[] = {&p};
    hipError_t e = hipLaunchCooperativeKernel((const void*)mega, dim3(grid_blocks), dim3(512), args, LDS_BYTES, stream);
    if (e != hipSuccess) fprintf(stderr, "cooperative launch failed: %s (grid %d)\n", hipGetErrorString(e), grid_blocks);
#endif
}
```

```cpp
#include <hip/hip_runtime.h>
#include <hip/hip_cooperative_groups.h>
#include <cstdio>
namespace cg = cooperative_groups;

#ifndef MULTI_LAUNCH
#define MULTI_LAUNCH 0
#endif
#ifndef REPMASK
#define REPMASK 0
#endif

#define LAS __attribute__((address_space(3)))
typedef unsigned short bf16_t;
typedef short bf16x8 __attribute__((ext_vector_type(8)));
typedef float f32x2 __attribute__((ext_vector_type(2)));
typedef float f32x4 __attribute__((ext_vector_type(4)));
typedef float f32x16 __attribute__((ext_vector_type(16)));
typedef unsigned u32x2 __attribute__((ext_vector_type(2)));
typedef unsigned u32x4 __attribute__((ext_vector_type(4)));

constexpr int D = 1024, NTOK = 16384, NCTX = 8192, DFF = 2816, NFF1 = 5632;
constexpr float ALPHA = 1.681792830507429f;
constexpr float LN_EPS = 1e-5f;
constexpr int LDS_BYTES = 131072 + 16 + 8 * 192 * 4;
constexpr int NPH = 28;
constexpr int XCD_BAR_WORDS_C = 3456;
constexpr int LDS_ST_OFF = 131072;
constexpr int LDS_COL_OFF = 131072 + 16;

constexpr size_t WS_W1 = 0;
constexpr size_t WS_W2 = WS_W1 + (size_t)4 * 5632 * 1024 * 2;
constexpr size_t WS_WG = WS_W2 + (size_t)4 * 1024 * 2816 * 2;
constexpr size_t WS_WP = WS_WG + (size_t)2 * 2048 * 1024 * 2;
constexpr size_t WS_MOD = WS_WP + (size_t)2 * 4 * 256 * 256 * 2;
constexpr size_t WS_ST = WS_MOD + (size_t)4 * 5 * 6144 * 4;
constexpr size_t WS_Z = WS_ST + (size_t)NTOK * 64 * 4;
constexpr size_t WS_Y = WS_Z + (size_t)NTOK * D * 4;
constexpr size_t WS_P = WS_Y + (size_t)2 * NTOK * D * 4;
constexpr size_t WS_Q = WS_P + (size_t)NTOK * D * 2;
constexpr size_t WS_BAR = WS_Q + (size_t)NTOK * D * 2;
constexpr size_t WS_E = WS_BAR + (size_t)XCD_BAR_WORDS_C * 4;
constexpr size_t WS_MR1 = WS_E + (size_t)32 * 2 * 64 * 64 * 8;
constexpr size_t WS_MR2 = WS_MR1 + (size_t)NTOK * 8;
constexpr size_t WS_END = WS_MR2 + (size_t)NTOK * 8;

struct Params {
    const float* in[25];
    float* out;
    unsigned char* ws;
    int ph_lo, ph_hi, wv, pad;
};

__device__ __forceinline__ unsigned cvt_pk_bf16(float lo, float hi) { unsigned r; asm("v_cvt_pk_bf16_f32 %0, %1, %2" : "=v"(r) : "v"(lo), "v"(hi)); return r; }
__device__ __forceinline__ float bf_lo(unsigned w) { return __uint_as_float(w << 16); }
__device__ __forceinline__ float bf_hi(unsigned w) { return __uint_as_float(w & 0xffff0000u); }
__device__ __forceinline__ float sigmoidf_(float x) { return __builtin_amdgcn_rcpf(1.0f + __expf(-x)); }
__device__ __forceinline__ float gelu_tanh(float x) { const float a = 1.5957691216057308f * (x + 0.044715f * x * x * x); return x * sigmoidf_(a); }
__device__ __forceinline__ int lane_id_() { int l; asm volatile("v_mbcnt_lo_u32_b32 %0, -1, 0\n\tv_mbcnt_hi_u32_b32 %0, -1, %0" : "=v"(l)); return l; }
__device__ __forceinline__ int opaque_tid(int wv) { int t = (wv << 6) | lane_id_(); asm volatile("" : "+v"(t)); return t; }
__device__ __forceinline__ int opaque_bid() { int b = blockIdx.x; asm volatile("" : "+s"(b)); return b; }
__device__ __forceinline__ int opaque_s(int v) { asm volatile("" : "+s"(v)); return v; }
__device__ __forceinline__ int cond_of_row(int row) { return row < NCTX ? 0 : 1 + ((row - NCTX) >> 11); }


#define XB_TMO      128
#define XB_XCNT(j)  (256  + 64 * (j))
#define XB_XSUB(j)  (1280 + 64 * (j))
#define XB_XGEN(j)  (2304 + 64 * (j))
#define XB_TOP      3328
#define XB_TOPGEN   3392
#define XCD_BAR_WORDS 3456
#define XB_SPIN_CAP (1u << 20)
__device__ __forceinline__ unsigned xb_ld(unsigned* p)              { return __hip_atomic_load(p, __ATOMIC_RELAXED, __HIP_MEMORY_SCOPE_AGENT); }
__device__ __forceinline__ unsigned xb_add(unsigned* p, unsigned v) { return __hip_atomic_fetch_add(p, v, __ATOMIC_RELAXED, __HIP_MEMORY_SCOPE_AGENT); }
__device__ __forceinline__ unsigned xb_xcc_id() { return (unsigned)__builtin_amdgcn_s_getreg((3 << 11) | 20) & 0xFu; }
#define XB_SPIN(cond, bar) do { unsigned _sp = 0; while (cond) { __builtin_amdgcn_s_sleep(1); \
    if ((++_sp & 255u) == 0u) { if (xb_ld(&(bar)[XB_TMO])) break; if (_sp > XB_SPIN_CAP) { atomicAdd(&(bar)[XB_TMO], 1u); break; } } } } while (0)
struct XcdBarrier { unsigned* bar; unsigned x; volatile LAS unsigned* st; };
__device__ __forceinline__ XcdBarrier xcd_barrier_post(unsigned* bar, volatile LAS unsigned* st, bool leader) {
    XcdBarrier b; b.bar = bar; b.x = xb_xcc_id(); b.st = st;
    if (leader) (void)xb_add(&bar[XB_XCNT(b.x)], 1u);
    return b;
}
__device__ __forceinline__ void xcd_barrier_complete(unsigned* bar, unsigned x, unsigned& nloc, unsigned& nx) {
    const unsigned G = gridDim.x * gridDim.y * gridDim.z;
    unsigned sum, cnt, mine, sp = 0u;
    for (;;) {
        sum = 0u; cnt = 0u; mine = 0u;
#pragma unroll
        for (unsigned j = 0; j < 16; ++j) { const unsigned c = xb_ld(&bar[XB_XCNT(j)]); sum += c; cnt += (c > 0u) ? 1u : 0u; mine = (j == x) ? c : mine; }
        if (sum == G) break;
        __builtin_amdgcn_s_sleep(1);
        if ((++sp & 255u) == 0u) { if (xb_ld(&bar[XB_TMO])) break; if (sp > XB_SPIN_CAP) { atomicAdd(&bar[XB_TMO], 1u); break; } }
    }
    nloc = mine > 0u ? mine : 1u; nx = cnt > 0u ? cnt : 1u;
}
__device__ __forceinline__ void xcd_barrier(const XcdBarrier& b, bool leader) {
    asm volatile("s_waitcnt vmcnt(0)" ::: "memory");
    __syncthreads();
    if (leader) {
        unsigned* bar = b.bar;
        __builtin_amdgcn_s_waitcnt(0);
        unsigned nloc = b.st[0], nx = b.st[1];
        if (nloc == 0u) { xcd_barrier_complete(bar, b.x, nloc, nx); b.st[0] = nloc; b.st[1] = nx; }
        const unsigned old = xb_add(&bar[XB_XSUB(b.x)], 1u);
        const unsigned gen = old / nloc;
        if (old + 1u == (gen + 1u) * nloc) {
            __builtin_amdgcn_fence(__ATOMIC_RELEASE, "agent");
            asm volatile("s_waitcnt vmcnt(0)" ::: "memory");
            const unsigned og = xb_add(&bar[XB_TOP], 1u);
            const unsigned tg = og / nx;
            if (og + 1u == (tg + 1u) * nx) xb_add(&bar[XB_TOPGEN], 1u);
            else XB_SPIN(xb_ld(&bar[XB_TOPGEN]) == tg, bar);
            __builtin_amdgcn_fence(__ATOMIC_ACQUIRE, "agent");
            xb_add(&bar[XB_XGEN(b.x)], 1u);
            asm volatile("s_waitcnt vmcnt(0)" ::: "memory");
        } else {
            XB_SPIN(xb_ld(&bar[XB_XGEN(b.x)]) == gen, bar);
            __builtin_amdgcn_fence(__ATOMIC_ACQUIRE, "agent");
            asm volatile("s_waitcnt vmcnt(0)" ::: "memory");
        }
    }
    __syncthreads();
}

__device__ __forceinline__ void adaln_item(const Params& p, int it, LAS float* lds) {
    const int tid = opaque_tid(p.wv);
    const int layer = it / 96, c0 = (it % 96) * 64;
    LAS float* s = lds;
    LAS float* red = lds + 5120;
    for (int e = tid; e < 5120; e += 512) { const int cnd = e >> 10, k = e & 1023; const float v = cnd == 0 ? p.in[5][k] : p.in[4][(cnd - 1) * 1024 + k]; s[e] = v * sigmoidf_(v); }
    __syncthreads();
    const int cgp = tid & 15, ks = tid >> 4;
    f32x4 acc[5];
#pragma unroll
    for (int c = 0; c < 5; ++c) acc[c] = (f32x4){0.f, 0.f, 0.f, 0.f};
    const float* base = p.in[6] + (size_t)layer * 1024 * 6144 + c0 + cgp * 4;
#pragma unroll 8
    for (int kk = 0; kk < 32; ++kk) { const int k = ks * 32 + kk; const f32x4 w = *(const f32x4*)(base + (size_t)k * 6144);
#pragma unroll
        for (int c = 0; c < 5; ++c) acc[c] += s[c * 1024 + k] * w; }
#pragma unroll
    for (int c = 0; c < 5; ++c) *(LAS f32x4*)(red + (ks * 5 + c) * 64 + cgp * 4) = acc[c];
    __syncthreads();
    if (tid < 320) { const int cnd = tid >> 6, col = tid & 63; float a = p.in[7][layer * 6144 + c0 + col];
        for (int k2 = 0; k2 < 32; ++k2) a += red[(k2 * 5 + cnd) * 64 + col];
        ((float*)(p.ws + WS_MOD))[(layer * 5 + cnd) * 6144 + c0 + col] = a; }
    __syncthreads();
}

struct TJob { const float* srcA; const float* srcB; bf16_t* dst; int src_ld, dst_ld, k0, c0; bool inter; };
struct WPtrs { const float* gate; const float* up; const float* down; const float* glu; const float* pool; unsigned char* ws; };
__device__ __forceinline__ TJob decode_job(const WPtrs& p, int idx) {
    TJob j;
    if (idx < 5632) { const int layer = idx / 1408, r = idx % 1408, kt = r / 88, ct = r % 88;
        j.srcA = p.gate + (size_t)layer * 1024 * 2816; j.srcB = p.up + (size_t)layer * 1024 * 2816; j.src_ld = 2816; j.k0 = kt * 64; j.c0 = ct * 64; j.inter = true; j.dst = (bf16_t*)(p.ws + WS_W1) + (size_t)layer * 5632 * 1024; j.dst_ld = 1024;
    } else if (idx < 8448) { const int r0 = idx - 5632, layer = r0 / 704, r = r0 % 704, kt = r / 16, ct = r % 16;
        j.srcA = p.down + (size_t)layer * 2816 * 1024; j.srcB = j.srcA; j.src_ld = 1024; j.k0 = kt * 64; j.c0 = ct * 64; j.inter = false; j.dst = (bf16_t*)(p.ws + WS_W2) + (size_t)layer * 1024 * 2816; j.dst_ld = 2816;
    } else if (idx < 9472) { const int r0 = idx - 8448, jj = r0 / 512, r = r0 % 512, kt = r / 32, ct = r % 32;
        j.srcA = p.glu + (size_t)jj * 1024 * 2048; j.srcB = j.srcA + 1024; j.src_ld = 2048; j.k0 = kt * 64; j.c0 = ct * 64; j.inter = true; j.dst = (bf16_t*)(p.ws + WS_WG) + (size_t)jj * 2048 * 1024; j.dst_ld = 1024;
    } else { const int r0 = idx - 9472, jg = r0 / 16, r = r0 % 16, kt = r / 4, ct = r % 4;
        j.srcA = p.pool + (size_t)jg * 65536; j.srcB = j.srcA; j.src_ld = 256; j.k0 = kt * 64; j.c0 = ct * 64; j.inter = false; j.dst = (bf16_t*)(p.ws + WS_WP) + (size_t)jg * 65536; j.dst_ld = 256; }
    return j;
}
__device__ __forceinline__ int job_idx(int list, int j) {
    if (list == 0) { if (j < 1408) return j; if (j < 2112) return 5632 + (j - 1408); if (j < 3136) return 8448 + (j - 2112); return 9472 + (j - 3136); }
    return j < 1408 ? list * 1408 + j : 5632 + list * 704 + (j - 1408);
}
__device__ __forceinline__ void transpose_list(const Params& pp, LAS float* lds, int list, int nj, int first, int stride) {
    const WPtrs p{pp.in[22], pp.in[23], pp.in[24], pp.in[18], pp.in[20], pp.ws};
    const int tid = opaque_tid(pp.wv), l64 = tid & 63, kk0 = tid >> 6, c = tid >> 3, ks = tid & 7;
    for (int base = first; base < nj; base += 4 * stride) {
        float vals[4][8]; int cl[4];
#pragma unroll
        for (int q = 0; q < 4; ++q) { const int jn = base + q * stride;
            if (jn < nj) { const TJob j = decode_job(p, job_idx(list, jn)); const float* sp;
                if (j.inter) { const int n = l64 >> 5, oo = l64 & 31; sp = (n ? j.srcB : j.srcA) + (j.c0 >> 1) + oo; cl[q] = (oo >> 4) * 32 + n * 16 + (oo & 15); }
                else { sp = j.srcA + j.c0 + l64; cl[q] = l64; }
#pragma unroll
                for (int i8 = 0; i8 < 8; ++i8) vals[q][i8] = sp[(size_t)(j.k0 + kk0 + i8 * 8) * j.src_ld]; } }
#pragma unroll
        for (int q = 0; q < 4; ++q) { if (base + q * stride < nj) {
#pragma unroll
                for (int i8 = 0; i8 < 8; ++i8) lds[q * 4160 + (kk0 + i8 * 8) * 65 + cl[q]] = vals[q][i8]; } }
        __syncthreads();
#pragma unroll
        for (int q = 0; q < 4; ++q) { const int jn = base + q * stride;
            if (jn < nj) { const TJob j = decode_job(p, job_idx(list, jn)); float v[8];
#pragma unroll
                for (int e = 0; e < 8; ++e) v[e] = lds[q * 4160 + (ks * 8 + e) * 65 + c];
                u32x4 w; w.x = cvt_pk_bf16(v[0], v[1]); w.y = cvt_pk_bf16(v[2], v[3]); w.z = cvt_pk_bf16(v[4], v[5]); w.w = cvt_pk_bf16(v[6], v[7]);
                *(u32x4*)(j.dst + (size_t)(j.c0 + c) * j.dst_ld + j.k0 + ks * 8) = w; } }
        __syncthreads();
    }
}
__device__ __forceinline__ void phase_w0(const Params& p, LAS unsigned char* lds8) {
    LAS float* lds = (LAS float*)lds8;
    const int NADA = 384, G = gridDim.x;
    const int bid = opaque_bid();
    for (int it = bid; it < NADA; it += G) adaln_item(p, it, lds);
    transpose_list(p, lds, 0, 3264, bid, G);
}
__device__ __forceinline__ void deferred_weights(const Params& p, LAS unsigned char* lds8, int list, int nunits) {
    const int G = gridDim.x, rem = nunits % G, c = opaque_bid();
    if (rem == 0) transpose_list(p, (LAS float*)lds8, list, 2112, c, G);
    else if (c >= rem) transpose_list(p, (LAS float*)lds8, list, 2112, c - rem, G - rem);
}

__device__ __forceinline__ void store_bf16x8(bf16_t* dst, const f32x4 a, const f32x4 b) {
    u32x4 w; w.x = cvt_pk_bf16(a[0], a[1]); w.y = cvt_pk_bf16(a[2], a[3]); w.z = cvt_pk_bf16(b[0], b[1]); w.w = cvt_pk_bf16(b[2], b[3]);
    *(u32x4*)dst = w;
}

__device__ __forceinline__ void phase_prep0(const Params& p) {
    const int tid_ = opaque_tid(p.wv), bid_ = opaque_bid(); const int wid = tid_ >> 6, lane = tid_ & 63;
    const float* mod = (const float*)(p.ws + WS_MOD);
    bf16_t* P = (bf16_t*)(p.ws + WS_P);
    for (int g4 = bid_ * 8 + wid; g4 < NTOK / 4; g4 += gridDim.x * 8) {
        const int row0 = g4 * 4; const int cnd = cond_of_row(row0);
        const float* src = row0 < NCTX ? p.in[0] + (size_t)row0 * D : p.in[1] + (size_t)(row0 - NCTX) * D;
        const float* sh = mod + (0 * 5 + cnd) * 6144, *sc = sh + 1024;
        f32x4 x[4][2][2];
#pragma unroll
        for (int r = 0; r < 4; ++r)
#pragma unroll
            for (int j = 0; j < 2; ++j) { const int col = j * 512 + lane * 8; x[r][j][0] = *(const f32x4*)(src + r * D + col); x[r][j][1] = *(const f32x4*)(src + r * D + col + 4); }
#pragma unroll
        for (int j = 0; j < 2; ++j) { const int col = j * 512 + lane * 8;
            const f32x4 s0 = 1.0f + *(const f32x4*)(sc + col), s1 = 1.0f + *(const f32x4*)(sc + col + 4), b0 = *(const f32x4*)(sh + col), b1 = *(const f32x4*)(sh + col + 4);
#pragma unroll
            for (int r = 0; r < 4; ++r) store_bf16x8(P + (size_t)(row0 + r) * D + col, x[r][j][0] * s0 + b0, x[r][j][1] * s1 + b1); }
    }
}

__device__ __forceinline__ void phase_ln(const Params& p, int layer, int which, int npart, int mode) {
    const int tid_ = opaque_tid(p.wv), bid_ = opaque_bid(); const int wid = tid_ >> 6, lane = tid_ & 63;
    const float* mod = (const float*)(p.ws + WS_MOD);
    float* Z = which == 0 ? (float*)(p.ws + WS_Z) : p.out;
    const f32x2* ST = (const f32x2*)(p.ws + WS_ST);
    f32x2* MR = (f32x2*)(p.ws + (which == 0 ? WS_MR1 : WS_MR2));
    const float* lg = p.in[8] + (layer * 2 + which) * 1024, *lb = p.in[9] + (layer * 2 + which) * 1024;
    const bool rdz = which == 0 || mode != 0;
    for (int g4 = bid_ * 8 + wid; g4 < NTOK / 4; g4 += gridDim.x * 8) {
        const int row0 = g4 * 4;
        f32x2 st[4]; f32x4 z[4][2][2];
#pragma unroll
        for (int r = 0; r < 4; ++r) { st[r] = lane < npart ? ST[(size_t)(row0 + r) * 32 + lane] : (f32x2){0.f, 0.f};
            if (rdz) {
#pragma unroll
                for (int j = 0; j < 2; ++j) { const size_t off = (size_t)(row0 + r) * D + j * 512 + lane * 8; z[r][j][0] = *(const f32x4*)(Z + off); z[r][j][1] = *(const f32x4*)(Z + off + 4); } } }
        float mean[4], rstd[4];
#pragma unroll
        for (int r = 0; r < 4; ++r) {
#pragma unroll
            for (int o = 1; o < 64; o <<= 1) { st[r].x += __shfl_xor(st[r].x, o); st[r].y += __shfl_xor(st[r].y, o); }
            mean[r] = st[r].x * (1.0f / 1024.0f); const float var = fmaxf(st[r].y * (1.0f / 1024.0f) - mean[r] * mean[r], 0.f); rstd[r] = rsqrtf(var + LN_EPS); }
        if (lane < 4) { const int r = lane; const float m_ = r == 0 ? mean[0] : r == 1 ? mean[1] : r == 2 ? mean[2] : mean[3]; const float s_ = r == 0 ? rstd[0] : r == 1 ? rstd[1] : r == 2 ? rstd[2] : rstd[3]; MR[row0 + r] = (f32x2){m_, s_}; }
        if (!rdz) continue;
        const int cnd = cond_of_row(row0);
        const float* sh = nullptr; const float* sc = nullptr; bf16_t* dst = nullptr;
        if (which == 0) { sh = mod + (layer * 5 + cnd) * 6144 + 3 * 1024; sc = sh + 1024; dst = (bf16_t*)(p.ws + WS_Q); }
        else if (mode == 1) { sh = mod + ((layer + 1) * 5 + cnd) * 6144; sc = sh + 1024; dst = (bf16_t*)(p.ws + WS_P); }
#pragma unroll
        for (int j = 0; j < 2; ++j) { const int col = j * 512 + lane * 8;
            const f32x4 g0 = *(const f32x4*)(lg + col), g1 = *(const f32x4*)(lg + col + 4), b0 = *(const f32x4*)(lb + col), b1 = *(const f32x4*)(lb + col + 4);
            f32x4 s0 = {0.f, 0.f, 0.f, 0.f}, s1 = s0, h0 = s0, h1 = s0;
            if (dst) { s0 = 1.0f + *(const f32x4*)(sc + col); s1 = 1.0f + *(const f32x4*)(sc + col + 4); h0 = *(const f32x4*)(sh + col); h1 = *(const f32x4*)(sh + col + 4); }
#pragma unroll
            for (int r = 0; r < 4; ++r) { const size_t off = (size_t)(row0 + r) * D + col;
                const f32x4 x0 = (z[r][j][0] - mean[r]) * rstd[r] * g0 + b0, x1 = (z[r][j][1] - mean[r]) * rstd[r] * g1 + b1;
                if (dst) store_bf16x8(dst + off, x0 * s0 + h0, x1 * s1 + h1);
                else { *(f32x4*)(Z + off) = x0; *(f32x4*)(Z + off + 4) = x1; } } }
    }
}

__device__ __forceinline__ void phase_comb(const Params& p, int jj) {
    const int tid_ = opaque_tid(p.wv), bid_ = opaque_bid(); const int wid = tid_ >> 6, lane = tid_ & 63;
    const bf16_t* P = (const bf16_t*)(p.ws + WS_P);
    const float* YF = (const float*)(p.ws + WS_Y), *YB = YF + (size_t)NTOK * D;
    bf16_t* Q = (bf16_t*)(p.ws + WS_Q);
    const float* dsk = p.in[17] + jj * 1024;
    for (int g2 = bid_ * 8 + wid; g2 < NTOK / 2; g2 += gridDim.x * 8) {
        const int row0 = g2 * 2;
        u32x4 uw[2][2]; f32x4 yf[2][2][2], yb[2][2][2];
#pragma unroll
        for (int r = 0; r < 2; ++r)
#pragma unroll
            for (int j = 0; j < 2; ++j) { const size_t off = (size_t)(row0 + r) * D + j * 512 + lane * 8;
                uw[r][j] = *(const u32x4*)(P + off); yf[r][j][0] = *(const f32x4*)(YF + off); yf[r][j][1] = *(const f32x4*)(YF + off + 4); yb[r][j][0] = *(const f32x4*)(YB + off); yb[r][j][1] = *(const f32x4*)(YB + off + 4); }
#pragma unroll
        for (int j = 0; j < 2; ++j) { const int col = j * 512 + lane * 8; const f32x4 d0 = *(const f32x4*)(dsk + col), d1 = *(const f32x4*)(dsk + col + 4);
#pragma unroll
            for (int r = 0; r < 2; ++r) { const u32x4 w = uw[r][j];
                const f32x4 u0 = {bf_lo(w.x), bf_hi(w.x), bf_lo(w.y), bf_hi(w.y)}, u1 = {bf_lo(w.z), bf_hi(w.z), bf_lo(w.w), bf_hi(w.w)};
                f32x4 y0 = u0 * d0 + yf[r][j][0] + yb[r][j][0], y1 = u1 * d1 + yf[r][j][1] + yb[r][j][1];
#pragma unroll
                for (int e = 0; e < 4; ++e) { y0[e] = gelu_tanh(y0[e]); y1[e] = gelu_tanh(y1[e]); }
                store_bf16x8(Q + (size_t)(row0 + r) * D + col, y0, y1); } }
    }
}

template <int K> __device__ __forceinline__ void pool2d_task(const float* X, const f32x2* MR, const float* lg, const float* mod, bf16_t* Q, int layer, int b, int c, int ch) {
    const int clo = max(c - K / 2, 0), chi = min(c - K / 2 + K, 64);
    const size_t tb = (size_t)(NCTX + b * 2048);
    f32x2 hs[32];
#pragma unroll
    for (int r = 0; r < 32; ++r) hs[r] = (f32x2){0.f, 0.f};
    for (int cc = clo; cc < chi; ++cc) {
        const float* xp = X + (tb + cc) * D + ch; const f32x2* mp = MR + tb + cc;
#pragma unroll
        for (int rh = 0; rh < 2; ++rh) {
            f32x2 t_[16], m_[16];
#pragma unroll
            for (int r = 0; r < 16; ++r) { t_[r] = *(const f32x2*)(xp + (size_t)(rh * 16 + r) * 64 * D); m_[r] = mp[(rh * 16 + r) * 64]; }
#pragma unroll
            for (int r = 0; r < 16; ++r) hs[rh * 16 + r] += (t_[r] - m_[r].x) * m_[r].y; } }
    const f32x2 sc = (1.0f + *(const f32x2*)(mod + (layer * 5 + 1 + b) * 6144 + 1024 + ch)) * *(const f32x2*)(lg + ch);
#pragma unroll
    for (int r = 0; r < 32; ++r) { const int rlo = (r - K / 2) < 0 ? 0 : (r - K / 2), rhi = (r - K / 2 + K) > 32 ? 32 : (r - K / 2 + K);
        f32x2 t = {0.f, 0.f};
#pragma unroll
        for (int rr = rlo; rr < rhi; ++rr) t += hs[rr];
        const float inv = 1.0f / (float)((rhi - rlo) * (chi - clo));
        const size_t off = (tb + r * 64 + c) * D + ch;
        const f32x2 mr = MR[tb + r * 64 + c];
        const f32x2 xc = (*(const f32x2*)(X + off) - mr.x) * mr.y;
        const f32x2 o = (t * inv - xc) * sc;
        *(unsigned*)(Q + off) = cvt_pk_bf16(o.x, o.y); }
}
template <int K> __device__ __forceinline__ void pool1d_task(const float* X, const f32x2* MR, const float* lg, const float* mod, bf16_t* Q, int layer, int b, int t0, int ch) {
    const size_t tb = (size_t)b * 256;
    f32x2 v[16 + K];
#pragma unroll
    for (int i = 0; i < 16 + K; ++i) { const int t = t0 - K / 2 + i;
        if (t >= 0 && t < 256) { const f32x2 mr = MR[tb + t]; v[i] = (*(const f32x2*)(X + (tb + t) * D + ch) - mr.x) * mr.y; } else v[i] = (f32x2){0.f, 0.f}; }
    const f32x2 sc = (1.0f + *(const f32x2*)(mod + (layer * 5 + 0) * 6144 + 1024 + ch)) * *(const f32x2*)(lg + ch);
#pragma unroll
    for (int i = 0; i < 16; ++i) { const int t = t0 + i; const int lo = max(t - K / 2, 0), hi = min(t - K / 2 + K, 256);
        f32x2 s2 = {0.f, 0.f};
#pragma unroll
        for (int k2 = 0; k2 < K; ++k2) s2 += v[i + k2];
        const float inv = 1.0f / (float)(hi - lo);
        const f32x2 o = (s2 * inv - v[i + K / 2]) * sc;
        *(unsigned*)(Q + (tb + t) * D + ch) = cvt_pk_bf16(o.x, o.y); }
}
__device__ __forceinline__ void phase_poolprep(const Params& p, int layer) {
    const int tid_ = opaque_tid(p.wv), bid_ = opaque_bid(); const int wid = tid_ >> 6, lane = tid_ & 63;
    const float* X = p.out; const float* mod = (const float*)(p.ws + WS_MOD); bf16_t* Q = (bf16_t*)(p.ws + WS_Q);
    const f32x2* MR = (const f32x2*)(p.ws + WS_MR2); const float* lg = p.in[8] + ((layer - 1) * 2 + 1) * 1024;
    const int nslots = gridDim.x * 8;
    for (int t = wid * gridDim.x + bid_; t < 2048 + 4096; t += nslots) {
        if (t < 2048) { const int gi = 3 - (t >> 9), r = t & 511, b = r >> 7, c = (r >> 1) & 63, half = r & 1; const int ch = gi * 256 + half * 128 + lane * 2;
            if (gi == 3) pool2d_task<16>(X, MR, lg, mod, Q, layer, b, c, ch); else if (gi == 2) pool2d_task<8>(X, MR, lg, mod, Q, layer, b, c, ch);
            else if (gi == 1) pool2d_task<4>(X, MR, lg, mod, Q, layer, b, c, ch); else pool2d_task<2>(X, MR, lg, mod, Q, layer, b, c, ch);
        } else { const int u = t - 2048; const int gi = 3 - (u >> 10), r = u & 1023, b = r >> 5, seg = (r >> 1) & 15, half = r & 1; const int ch = gi * 256 + half * 128 + lane * 2;
            if (gi == 3) pool1d_task<16>(X, MR, lg, mod, Q, layer, b, seg * 16, ch); else if (gi == 2) pool1d_task<8>(X, MR, lg, mod, Q, layer, b, seg * 16, ch);
            else if (gi == 1) pool1d_task<4>(X, MR, lg, mod, Q, layer, b, seg * 16, ch); else pool1d_task<2>(X, MR, lg, mod, Q, layer, b, seg * 16, ch);
        }
    }
}

constexpr int S5_ROWB = 272;
constexpr int S5_WAVE_LDS = 32 * S5_ROWB;

template <int MODE>
__device__ __forceinline__ void s5_task(const Params& p, int jj, int task, LAS unsigned char* wl, int lane) {
    const int pair = task >> 7, dir = (task >> 6) & 1, g = task & 63;
    constexpr int L = 256, ntile = 16;
    const int half = lane >> 5, p0 = lane & 31;
    const int pidx = (jj * 2 + dir) * 64 + g;
    const float dt = expf(p.in[12][pidx]);
    float ar[2], ai[2]; bf16x8 Bre[2], Bim[2];
#pragma unroll
    for (int s = 0; s < 2; ++s) { const int P = p0 + 32 * s;
        const float are = p.in[10][pidx * 64 + P], aim = p.in[11][pidx * 64 + P];
        const float mag = expf(are * dt), ang = aim * dt; float sn, cs; sn = sinf(ang); cs = cosf(ang);
        const float abr = mag * cs, abi = mag * sn, den = are * are + aim * aim, nr = abr - 1.0f;
        const float cr = (nr * are + abi * aim) / den, ci = (abi * are - nr * aim) / den;
        const float* br = p.in[13] + ((size_t)(pidx * 64 + P) * 16 + half * 8), *bi = p.in[14] + ((size_t)(pidx * 64 + P) * 16 + half * 8);
        const f32x4 br0 = *(const f32x4*)br, br1 = *(const f32x4*)(br + 4), bi0 = *(const f32x4*)bi, bi1 = *(const f32x4*)(bi + 4);
        const f32x4 r0 = cr * br0 - ci * bi0, r1 = cr * br1 - ci * bi1, i0 = cr * bi0 + ci * br0, i1 = cr * bi1 + ci * br1;
        u32x4 wr_, wi_;
        wr_.x = cvt_pk_bf16(r0[0], r0[1]); wr_.y = cvt_pk_bf16(r0[2], r0[3]); wr_.z = cvt_pk_bf16(r1[0], r1[1]); wr_.w = cvt_pk_bf16(r1[2], r1[3]);
        wi_.x = cvt_pk_bf16(i0[0], i0[1]); wi_.y = cvt_pk_bf16(i0[2], i0[3]); wi_.z = cvt_pk_bf16(i1[0], i1[1]); wi_.w = cvt_pk_bf16(i1[2], i1[3]);
        Bre[s] = __builtin_bit_cast(bf16x8, wr_); Bim[s] = __builtin_bit_cast(bf16x8, wi_);
        ar[s] = abr; ai[s] = abi; }
    const int csc = pair * 2 + half;
    f32x2* E = (f32x2*)(p.ws + WS_E);
    float sr[2], si[2];
#pragma unroll
    for (int s = 0; s < 2; ++s) { sr[s] = 0.f; si[s] = 0.f; }
    if (MODE == 2) {
        const int b = csc >> 3, k = csc & 7;
#pragma unroll
        for (int s = 0; s < 2; ++s) { const int P = p0 + 32 * s;
            float qr = ar[s], qi = ai[s];
#pragma unroll
            for (int e = 0; e < 8; ++e) { const float t = qr * qr - qi * qi; qi = 2.0f * qr * qi; qr = t; }
            const size_t ix = ((size_t)((b * 2 + jj) * 2 + dir) * 64 + g) * 64 + P;
            float hr = p.in[2][ix], hi = p.in[3][ix];
            for (int e = 0; e < 7; ++e) { const int kk = dir ? 7 - e : e;
                const bool pre = dir ? (kk > k) : (kk < k);
                const f32x2 ev = E[((size_t)((b * 8 + kk) * 2 + dir) * 64 + g) * 64 + P];
                if (pre) { const float t = qr * hr - qi * hi + ev.x; hi = qr * hi + qi * hr + ev.y; hr = t; } }
            sr[s] = hr; si[s] = hi; }
    }
    bf16x8 Cop[4];
    if (MODE != 1) { const int n = lane & 15, kq = lane >> 4;
#pragma unroll
      for (int ks = 0; ks < 4; ++ks) { const int pp = ks * 16 + kq * 4;
          const f32x4 cre = *(const f32x4*)(p.in[15] + ((size_t)(pidx * 16 + n) * 64 + pp)), cim = *(const f32x4*)(p.in[16] + ((size_t)(pidx * 16 + n) * 64 + pp));
          u32x4 w; w.x = cvt_pk_bf16(cre[0], -cim[0]); w.y = cvt_pk_bf16(cre[1], -cim[1]); w.z = cvt_pk_bf16(cre[2], -cim[2]); w.w = cvt_pk_bf16(cre[3], -cim[3]);
          Cop[ks] = __builtin_bit_cast(bf16x8, w); } }
    const int m = lane & 31, lc = (m >> 2) & 1, ltau = ((m >> 3) << 2) | (m & 3), kh = lane >> 5;
    const int lch = pair * 2 + lc; const int lbase = MODE == 0 ? lch * 256 : NCTX + lch * 256;
    const bf16_t* Pu = (const bf16_t*)(p.ws + WS_P) + g * 16 + kh * 8;
    float* Yd = (float*)(p.ws + WS_Y) + (size_t)dir * NTOK * D + g * 16 + (lane >> 4) * 4;
    const int otau = lane & 15;
    auto tok_of = [&](int base, int ti, int tau) { const int step = ti * 16 + tau; return base + (dir ? (L - 1 - step) : step); };
    bf16x8 u0 = *(const bf16x8*)(Pu + (size_t)tok_of(lbase, 0, ltau) * D);
    bf16x8 u1 = *(const bf16x8*)(Pu + (size_t)tok_of(lbase, 1, ltau) * D);
    const f32x16 zero16 = {0.f, 0.f, 0.f, 0.f, 0.f, 0.f, 0.f, 0.f, 0.f, 0.f, 0.f, 0.f, 0.f, 0.f, 0.f, 0.f};
    for (int ti = 0; ti < ntile; ++ti) {
        const int tn = min(ti + 2, ntile - 1);
        const bf16x8 u2 = *(const bf16x8*)(Pu + (size_t)tok_of(lbase, tn, ltau) * D);
        f32x16 dre[2], dim_[2];
        asm volatile("s_nop 4\n\t"
                     "v_mfma_f32_32x32x16_bf16 %0, %4, %5, 0\n\t"
                     "v_mfma_f32_32x32x16_bf16 %1, %4, %6, 0\n\t"
                     "v_mfma_f32_32x32x16_bf16 %2, %4, %7, 0\n\t"
                     "v_mfma_f32_32x32x16_bf16 %3, %4, %8, 0\n\t"
                     "s_nop 15\n\ts_nop 15\n\ts_nop 7"
                     : "=&v"(dre[0]), "=&v"(dim_[0]), "=&v"(dre[1]), "=&v"(dim_[1])
                     : "v"(u0), "v"(Bre[0]), "v"(Bim[0]), "v"(Bre[1]), "v"(Bim[1]));
        float x0r = sr[0], x0i = si[0], x1r = sr[1], x1i = si[1];
#pragma unroll
        for (int i = 0; i < 16; ++i) {
            const float n0r = fmaf(ar[0], x0r, fmaf(-ai[0], x0i, dre[0][i])), n0i = fmaf(ar[0], x0i, fmaf(ai[0], x0r, dim_[0][i]));
            const float n1r = fmaf(ar[1], x1r, fmaf(-ai[1], x1i, dre[1][i])), n1i = fmaf(ar[1], x1i, fmaf(ai[1], x1r, dim_[1][i]));
            x0r = n0r; x0i = n0i; x1r = n1r; x1i = n1i;
            if (MODE != 1) { *(LAS unsigned*)(wl + (half * 16 + i) * S5_ROWB + p0 * 4) = cvt_pk_bf16(x0r, x0i);
                             *(LAS unsigned*)(wl + (half * 16 + i) * S5_ROWB + (p0 + 32) * 4) = cvt_pk_bf16(x1r, x1i); }
        }
        sr[0] = x0r; si[0] = x0i; sr[1] = x1r; si[1] = x1i;
        if (MODE != 1) {
            asm volatile("s_waitcnt lgkmcnt(0)" ::: "memory");
            __builtin_amdgcn_wave_barrier();
#pragma unroll
            for (int c = 0; c < 2; ++c) { f32x4 acc = {0.f, 0.f, 0.f, 0.f};
#pragma unroll
                for (int ks = 0; ks < 4; ++ks) { const bf16x8 sf = *(const LAS bf16x8*)(wl + (c * 16 + otau) * S5_ROWB + ks * 64 + (lane >> 4) * 16);
                    acc = __builtin_amdgcn_mfma_f32_16x16x32_bf16(Cop[ks], sf, acc, 0, 0, 0); }
                const int och = pair * 2 + c; const int obase = MODE == 0 ? och * 256 : NCTX + och * 256;
                *(f32x4*)(Yd + (size_t)tok_of(obase, ti, otau) * D) = acc; }
            asm volatile("s_waitcnt lgkmcnt(0)" ::: "memory");
            __builtin_amdgcn_wave_barrier();
        }
        u0 = u1; u1 = u2;
    }
    if (MODE == 0) { float* ore = p.out + (size_t)NTOK * D, *oim = ore + 32 * 2 * 2 * 64 * 64;
#pragma unroll
        for (int s = 0; s < 2; ++s) { const size_t ix = ((size_t)((csc * 2 + jj) * 2 + dir) * 64 + g) * 64 + p0 + 32 * s; ore[ix] = sr[s]; oim[ix] = si[s]; } }
    if (MODE == 1) {
#pragma unroll
        for (int s = 0; s < 2; ++s) E[((size_t)(csc * 2 + dir) * 64 + g) * 64 + p0 + 32 * s] = (f32x2){sr[s], si[s]}; }
}

__device__ __forceinline__ void s5_combine(const Params& p, int jj, bool lat, int idx, int c, int lane) {
    const int pair = idx >> 6, g = idx & 63, seq = pair * 2 + c; const int base = lat ? NCTX + seq * 256 : seq * 256;
    const bf16_t* P = (const bf16_t*)(p.ws + WS_P);
    const float* YF = (const float*)(p.ws + WS_Y), *YB = YF + (size_t)NTOK * D;
    bf16_t* Q = (bf16_t*)(p.ws + WS_Q);
    const float* dsk = p.in[17] + jj * 1024 + g * 16;
    const f32x4 d0 = *(const f32x4*)dsk, d1 = *(const f32x4*)(dsk + 4), d2 = *(const f32x4*)(dsk + 8), d3 = *(const f32x4*)(dsk + 12);
#pragma unroll
    for (int jp = 0; jp < 2; ++jp) {
        u32x4 uw[2][2]; f32x4 yf[2][4], yb[2][4];
#pragma unroll
        for (int r = 0; r < 2; ++r) { const size_t off = (size_t)(base + lane + 64 * (jp * 2 + r)) * D + g * 16;
            uw[r][0] = *(const u32x4*)(P + off); uw[r][1] = *(const u32x4*)(P + off + 8);
#pragma unroll
            for (int e = 0; e < 4; ++e) { yf[r][e] = *(const f32x4*)(YF + off + 4 * e); yb[r][e] = *(const f32x4*)(YB + off + 4 * e); } }
#pragma unroll
        for (int r = 0; r < 2; ++r) { const size_t off = (size_t)(base + lane + 64 * (jp * 2 + r)) * D + g * 16;
            const u32x4 w0 = uw[r][0], w1 = uw[r][1];
            f32x4 y0 = (f32x4){bf_lo(w0.x), bf_hi(w0.x), bf_lo(w0.y), bf_hi(w0.y)} * d0 + yf[r][0] + yb[r][0];
            f32x4 y1 = (f32x4){bf_lo(w0.z), bf_hi(w0.z), bf_lo(w0.w), bf_hi(w0.w)} * d1 + yf[r][1] + yb[r][1];
            f32x4 y2 = (f32x4){bf_lo(w1.x), bf_hi(w1.x), bf_lo(w1.y), bf_hi(w1.y)} * d2 + yf[r][2] + yb[r][2];
            f32x4 y3 = (f32x4){bf_lo(w1.z), bf_hi(w1.z), bf_lo(w1.w), bf_hi(w1.w)} * d3 + yf[r][3] + yb[r][3];
#pragma unroll
            for (int e = 0; e < 4; ++e) { y0[e] = gelu_tanh(y0[e]); y1[e] = gelu_tanh(y1[e]); y2[e] = gelu_tanh(y2[e]); y3[e] = gelu_tanh(y3[e]); }
            store_bf16x8(Q + off, y0, y1); store_bf16x8(Q + off + 8, y2, y3); }
    }
}

__device__ __forceinline__ void phase_s5(const Params& p, int jj, int sub, LAS unsigned char* lds) {
    const int tid_ = opaque_tid(p.wv), bid_ = opaque_bid(); const int wid = tid_ >> 6, lane = tid_ & 63;
    const int G = gridDim.x, nslots = G * 8, slot = wid * G + bid_;
    LAS unsigned char* wl = lds + wid * S5_WAVE_LDS;
    if (sub == 0) { for (int t = slot; t < 2048; t += nslots) s5_task<1>(p, jj, t, wl, lane); }
    for (int b4 = bid_; b4 < 256; b4 += G) {
        const int idx = b4 * 4 + (wid >> 1); const int task = ((idx >> 6) << 7) | ((wid & 1) << 6) | (idx & 63);
        if (sub == 0) s5_task<0>(p, jj, task, wl, lane); else s5_task<2>(p, jj, task, wl, lane);
        __syncthreads();
        s5_combine(p, jj, sub != 0, idx, wid & 1, lane);
    }
}

namespace pg8 {
constexpr int BM = 256, BK = 64, HALF = 128, HTB = HALF * BK * 2, NXCD = 8, WGM = 8;
__device__ __forceinline__ int lds_byte(int r, int c) { const int st = (r >> 4) * 2 + (c >> 5), rr = r & 15, cc = c & 31, ob = rr * 64 + cc * 2; return st * 1024 + (ob ^ (((ob >> 9) & 1) << 5)); }
__device__ __forceinline__ void stage_rc(int b, int& R, int& C) { const int st = b / 1024, sb = b % 1024, swz = sb ^ (((sb >> 9) & 1) << 5); R = (st >> 1) * 16 + swz / 64; C = (st & 1) * 32 + (swz % 64) / 2; }
struct Unit { int pm, pn; };
struct Gemm { const bf16_t* A; const bf16_t* Bt; int M, N, K, lda, acol; };
struct StaticOrder {
    int nM, nN, nwg, G, c;
    __device__ void init(int M, int N, int G_, int c_) { nM = M / BM; nN = N / BM; nwg = nM * nN; G = G_; c = c_; }
    __device__ bool next(int i, Unit& u) const {
        const long L = (long)i * G + c; if (L >= nwg) return false;
        int wgid = (int)L; { const int q = nwg / NXCD, r = nwg % NXCD, xcd = wgid % NXCD, off = wgid / NXCD; wgid = (xcd < r ? xcd * (q + 1) : r * (q + 1) + (xcd - r) * q) + off; }
        const int nig = WGM * nN, gid = wgid / nig, fm = gid * WGM, gsz = (nM - fm) < WGM ? (nM - fm) : WGM;
        u.pm = fm + ((wgid % nig) % gsz); u.pn = (wgid % nig) / gsz; return true;
    }
};

template <class Epi>
__device__ __forceinline__ void gemm_phase(LAS unsigned char* lds, const Gemm g, const StaticOrder& S, const Epi& E, int wv) {
    const int tid = opaque_tid(wv), wid = __builtin_amdgcn_readfirstlane(tid >> 6), lane = tid & 63, wr = wid >> 2, wc = wid & 3, fr = lane & 15, fq = lane >> 4;
    const int K = g.K, nt = K / BK, lda = g.lda;
    unsigned voffA[2], voffB[2];
#pragma unroll
    for (int i = 0; i < 2; ++i) { int R, C; stage_rc(tid * 16 + i * 8192, R, C); voffA[i] = (unsigned)(R * lda + C) * 2u; voffB[i] = (unsigned)(R * K + C) * 2u; }
    const size_t kstep = (size_t)(BK * 2);
    const size_t hstepA = (size_t)HALF * lda * 2, hstepB = (size_t)HALF * K * 2;
    const size_t tstepA = 2 * hstepA, tstepB = 2 * hstepB;
    const size_t acolb = (size_t)g.acol * 2;
    const unsigned ldsw = (unsigned)wid * 1024u;
    const int aoff = lds_byte(wr * 64 + fr, fq * 8), boff = lds_byte(wc * 32 + fr, fq * 8);
#define PG8_SA(b, h) (((b) * 2 + (h)) * HTB)
#define PG8_SB(b, h) ((4 + (b) * 2 + (h)) * HTB)
#define PG8_STAGE(bufoff, gbase, voff) do { _Pragma("unroll") for (int _i = 0; _i < 2; ++_i) \
        __builtin_amdgcn_global_load_lds((const unsigned*)((const char*)(gbase) + (voff)[_i]), (LAS unsigned*)(lds + (bufoff) + ldsw + _i * 8192), 16, 0, 0); } while (0)
#define PG8_LDA(dst, b, h) do { _Pragma("unroll") for (int m = 0; m < 4; ++m) _Pragma("unroll") for (int k = 0; k < 2; ++k) dst[m][k] = *(const LAS bf16x8*)(lds + PG8_SA(b, h) + aoff + m * 2048 + k * 1024); } while (0)
#define PG8_LDB(dst, b, h) do { _Pragma("unroll") for (int n = 0; n < 2; ++n) _Pragma("unroll") for (int k = 0; k < 2; ++k) dst[n][k] = *(const LAS bf16x8*)(lds + PG8_SB(b, h) + boff + n * 2048 + k * 1024); } while (0)
#define PG8_MMA(ai, bj, At, Bt) do { __builtin_amdgcn_s_setprio(1); _Pragma("unroll") for (int m = 0; m < 4; ++m) _Pragma("unroll") for (int n = 0; n < 2; ++n) _Pragma("unroll") for (int k = 0; k < 2; ++k) \
        acc[ai][bj][m][n] = __builtin_amdgcn_mfma_f32_16x16x32_bf16(Bt[n][k], At[m][k], acc[ai][bj][m][n], 0, 0, 0); __builtin_amdgcn_s_setprio(0); } while (0)
#define PG8_WAIT_V(n) asm volatile("s_waitcnt vmcnt(" #n ")" ::: "memory")
#define PG8_WAIT_L(n) asm volatile("s_waitcnt lgkmcnt(" #n ")" ::: "memory")
#define PG8_BAR __builtin_amdgcn_s_barrier()
#define PG8_SCHED __builtin_amdgcn_sched_barrier(0)
    Unit cur, nxt; int ui = 0;
    if (!S.next(0, cur)) return;
    f32x4 acc[2][2][4][2];
#pragma unroll
    for (int a = 0; a < 2; ++a)
#pragma unroll
        for (int b = 0; b < 2; ++b)
#pragma unroll
            for (int m = 0; m < 4; ++m)
#pragma unroll
                for (int n = 0; n < 2; ++n) acc[a][b][m][n] = (f32x4){0.f, 0.f, 0.f, 0.f};
    bf16x8 At[4][2], B0[2][2], B1[2][2];
    const char* cA = (const char*)g.A + (size_t)cur.pm * tstepA + (size_t)cur.pn * acolb; const char* cB = (const char*)g.Bt + (size_t)cur.pn * tstepB;
    PG8_STAGE(PG8_SB(0, 0), cB, voffB); PG8_STAGE(PG8_SA(0, 0), cA, voffA); PG8_STAGE(PG8_SB(0, 1), cB + hstepB, voffB); PG8_STAGE(PG8_SA(0, 1), cA + hstepA, voffA);
    if (wr == 1) PG8_BAR;
    PG8_WAIT_V(4); PG8_BAR;
    PG8_STAGE(PG8_SB(1, 0), cB + kstep, voffB); PG8_STAGE(PG8_SA(1, 0), cA + kstep, voffA); PG8_STAGE(PG8_SB(1, 1), cB + hstepB + kstep, voffB);
    PG8_WAIT_V(6); PG8_BAR;
    for (;;) {
        const bool has_next = S.next(ui + 1, nxt);
        const char* nA = has_next ? (const char*)g.A + (size_t)nxt.pm * tstepA + (size_t)nxt.pn * acolb : cA; const char* nB = has_next ? (const char*)g.Bt + (size_t)nxt.pn * tstepB : cB;
        for (int t = 0; t < nt; t += 2) {
            const bool last = (t == nt - 2);
            const char* a1 = cA + (size_t)(t + 1) * kstep;
            const char* a2 = last ? nA : cA + (size_t)(t + 2) * kstep; const char* b2 = last ? nB : cB + (size_t)(t + 2) * kstep;
            const char* a3 = a2 + kstep; const char* b3 = b2 + kstep;
            PG8_LDB(B0, 0, 0); PG8_SCHED; PG8_LDA(At, 0, 0); PG8_STAGE(PG8_SA(1, 1), a1 + hstepA, voffA);
            PG8_WAIT_L(8); PG8_BAR; PG8_WAIT_L(0); PG8_MMA(0, 0, At, B0); PG8_BAR; PG8_SCHED;
            PG8_LDB(B1, 0, 1); PG8_STAGE(PG8_SB(0, 0), b2, voffB);
            PG8_BAR; PG8_WAIT_L(0); PG8_MMA(0, 1, At, B1); PG8_BAR;
            PG8_LDA(At, 0, 1); PG8_STAGE(PG8_SA(0, 0), a2, voffA);
            PG8_BAR; PG8_WAIT_L(0); PG8_MMA(1, 0, At, B0); PG8_BAR; PG8_SCHED;
            PG8_STAGE(PG8_SB(0, 1), b2 + hstepB, voffB);
            PG8_WAIT_V(6); PG8_BAR; PG8_MMA(1, 1, At, B1); PG8_BAR;
            PG8_LDB(B0, 1, 0); PG8_SCHED; PG8_LDA(At, 1, 0); PG8_STAGE(PG8_SA(0, 1), a2 + hstepA, voffA);
            PG8_WAIT_L(8); PG8_BAR; PG8_WAIT_L(0); PG8_MMA(0, 0, At, B0); PG8_BAR; PG8_SCHED;
            PG8_LDB(B1, 1, 1); PG8_STAGE(PG8_SB(1, 0), b3, voffB);
            PG8_BAR; PG8_WAIT_L(0); PG8_MMA(0, 1, At, B1); PG8_BAR;
            PG8_LDA(At, 1, 1); PG8_STAGE(PG8_SA(1, 0), a3, voffA);
            PG8_BAR; PG8_WAIT_L(0); PG8_MMA(1, 0, At, B0); PG8_BAR; PG8_SCHED;
            PG8_STAGE(PG8_SB(1, 1), b3 + hstepB, voffB);
            PG8_WAIT_V(6); PG8_BAR; PG8_MMA(1, 1, At, B1); PG8_BAR;
        }
        E(acc, cur, wr, wc, fr, fq);
        if (!has_next) break;
#pragma unroll
        for (int a = 0; a < 2; ++a)
#pragma unroll
            for (int b = 0; b < 2; ++b)
#pragma unroll
                for (int m = 0; m < 4; ++m)
#pragma unroll
                    for (int n = 0; n < 2; ++n) acc[a][b][m][n] = (f32x4){0.f, 0.f, 0.f, 0.f};
        cur = nxt; cA = nA; cB = nB; ++ui;
    }
    PG8_WAIT_V(0);
    if (wr == 0) PG8_BAR;
    PG8_BAR;
#undef PG8_SA
#undef PG8_SB
#undef PG8_STAGE
#undef PG8_LDA
#undef PG8_LDB
#undef PG8_MMA
#undef PG8_WAIT_V
#undef PG8_WAIT_L
#undef PG8_BAR
#undef PG8_SCHED
}
}

__device__ __forceinline__ void stat_store(float s, float q, f32x2* ST, int row, int part, int fq) {
    s += __shfl_xor(s, 16); s += __shfl_xor(s, 32); q += __shfl_xor(q, 16); q += __shfl_xor(q, 32);
    if (fq == 0) ST[(size_t)row * 32 + part] = (f32x2){s, q};
}
struct ResSrc { const float* zlo; const float* zhi; const f32x2* mr; const float* lng; const float* lnb; };
struct EpiGlu {
    const float* bias; ResSrc R; const float* mod; float* Z; f32x2* ST;
    __device__ __forceinline__ void operator()(const f32x4 (&acc)[2][2][4][2], const pg8::Unit& u, int wr, int wc, int fr, int fq) const {
        const int cnd = u.pm < 32 ? 0 : 1 + ((u.pm - 32) >> 3);
        const float* xb = u.pm < 32 ? R.zlo : R.zhi; const float* g1 = mod + cnd * 6144 + 2 * 1024;
        int oc[2]; f32x4 bv[2], bg[2], gv[2], la[2], lb_[2];
#pragma unroll
        for (int bj = 0; bj < 2; ++bj) { oc[bj] = (u.pn * 8 + bj * 4 + wc) * 16 + 4 * fq; bv[bj] = *(const f32x4*)(bias + oc[bj]); bg[bj] = *(const f32x4*)(bias + 1024 + oc[bj]); gv[bj] = *(const f32x4*)(g1 + oc[bj]);
            if (R.mr) { la[bj] = ALPHA * *(const f32x4*)(R.lng + oc[bj]); lb_[bj] = ALPHA * *(const f32x4*)(R.lnb + oc[bj]); } else { la[bj] = (f32x4){ALPHA, ALPHA, ALPHA, ALPHA}; lb_[bj] = (f32x4){0.f, 0.f, 0.f, 0.f}; } }
#pragma unroll
        for (int ai = 0; ai < 2; ++ai) {
            f32x4 xr[4][2]; f32x2 mr[4];
#pragma unroll
            for (int m = 0; m < 4; ++m) { const int row = u.pm * 256 + ai * 128 + wr * 64 + m * 16 + fr; mr[m] = R.mr ? R.mr[row] : (f32x2){0.f, 1.f};
#pragma unroll
                for (int bj = 0; bj < 2; ++bj) xr[m][bj] = *(const f32x4*)(xb + (size_t)row * D + oc[bj]); }
#pragma unroll
            for (int m = 0; m < 4; ++m) { const int row = u.pm * 256 + ai * 128 + wr * 64 + m * 16 + fr; float s = 0.f, q = 0.f;
#pragma unroll
                for (int bj = 0; bj < 2; ++bj) { const f32x4 v = acc[ai][bj][m][0] + bv[bj], gt = acc[ai][bj][m][1] + bg[bj]; f32x4 o;
#pragma unroll
                    for (int e = 0; e < 4; ++e) o[e] = v[e] * sigmoidf_(gt[e]);
                    const f32x4 z = ((xr[m][bj] - mr[m].x) * mr[m].y) * la[bj] + lb_[bj] + gv[bj] * o;
                    *(f32x4*)(Z + (size_t)row * D + oc[bj]) = z; s += (z[0] + z[1]) + (z[2] + z[3]); q += (z[0] * z[0] + z[1] * z[1]) + (z[2] * z[2] + z[3] * z[3]); }
                stat_store(s, q, ST, row, u.pn * 4 + wc, fq); }
            asm volatile("" ::: "memory"); }
    }
};
struct EpiFfn1 {
    bf16_t* H;
    __device__ __forceinline__ void operator()(const f32x4 (&acc)[2][2][4][2], const pg8::Unit& u, int wr, int wc, int fr, int fq) const {
#pragma unroll
        for (int ai = 0; ai < 2; ++ai)
#pragma unroll
            for (int m = 0; m < 4; ++m) { const int row = u.pm * 256 + ai * 128 + wr * 64 + m * 16 + fr;
#pragma unroll
                for (int bj = 0; bj < 2; ++bj) { const int oc = (u.pn * 8 + bj * 4 + wc) * 16 + 4 * fq; const f32x4 gt = acc[ai][bj][m][0], up = acc[ai][bj][m][1]; f32x4 h;
#pragma unroll
                    for (int e = 0; e < 4; ++e) h[e] = gt[e] * sigmoidf_(gt[e]) * up[e];
                    u32x2 w; w.x = cvt_pk_bf16(h[0], h[1]); w.y = cvt_pk_bf16(h[2], h[3]); *(u32x2*)(H + (size_t)row * DFF + oc) = w; } }
    }
};
struct EpiRes {
    ResSrc R; const float* mod; int gchunk; const float* scale; float* Z; f32x2* ST; LAS float* colw;
    __device__ __forceinline__ void operator()(const f32x4 (&acc)[2][2][4][2], const pg8::Unit& u, int wr, int wc, int fr, int fq) const {
        const int cnd = u.pm < 32 ? 0 : 1 + ((u.pm - 32) >> 3);
        const float* gp = mod + cnd * 6144 + gchunk * 1024;
        const int col0 = u.pn * 256 + wc * 32 + 4 * fq;
        LAS float* cw = colw + (wr * 4 + wc) * 192;
        { const int lane = fq * 16 + fr;
          if (lane < 48) { const int arr = lane >> 4, idx = lane & 15, bj = idx >> 3, n = (idx >> 2) & 1, q4 = idx & 3; const int col = u.pn * 256 + wc * 32 + bj * 128 + n * 16 + q4 * 4;
              f32x4 v;
              if (arr == 0) { v = *(const f32x4*)(gp + col); if (scale) v *= *(const f32x4*)(scale + col); }
              else if (arr == 1) v = ALPHA * *(const f32x4*)(R.lng + col);
              else v = ALPHA * *(const f32x4*)(R.lnb + col);
              *(LAS f32x4*)(cw + arr * 64 + (bj * 2 + n) * 16 + q4 * 4) = v; }
          asm volatile("s_waitcnt lgkmcnt(0)" ::: "memory"); __builtin_amdgcn_wave_barrier(); }
#pragma unroll
        for (int ai = 0; ai < 2; ++ai)
#pragma unroll
            for (int mh = 0; mh < 2; ++mh) {
                f32x4 xr[2][2][2]; f32x2 mr[2];
#pragma unroll
                for (int m2 = 0; m2 < 2; ++m2) { const int row = u.pm * 256 + ai * 128 + wr * 64 + (mh * 2 + m2) * 16 + fr; mr[m2] = R.mr[row];
#pragma unroll
                    for (int bj = 0; bj < 2; ++bj)
#pragma unroll
                        for (int n = 0; n < 2; ++n) xr[m2][bj][n] = *(const f32x4*)(R.zlo + (size_t)row * D + col0 + bj * 128 + n * 16); }
                float s[2] = {0.f, 0.f}, q[2] = {0.f, 0.f};
#pragma unroll
                for (int bj = 0; bj < 2; ++bj)
#pragma unroll
                    for (int n = 0; n < 2; ++n) { const int col = col0 + bj * 128 + n * 16;
                        const f32x4 gv = *(const LAS f32x4*)(cw + (bj * 2 + n) * 16 + fq * 4), la = *(const LAS f32x4*)(cw + 64 + (bj * 2 + n) * 16 + fq * 4), lb_ = *(const LAS f32x4*)(cw + 128 + (bj * 2 + n) * 16 + fq * 4);
#pragma unroll
                        for (int m2 = 0; m2 < 2; ++m2) { const int m = mh * 2 + m2; const int row = u.pm * 256 + ai * 128 + wr * 64 + m * 16 + fr;
                            const f32x4 z = ((xr[m2][bj][n] - mr[m2].x) * mr[m2].y) * la + lb_ + gv * acc[ai][bj][m][n];
                            *(f32x4*)(Z + (size_t)row * D + col) = z; s[m2] += (z[0] + z[1]) + (z[2] + z[3]); q[m2] += (z[0] * z[0] + z[1] * z[1]) + (z[2] * z[2] + z[3] * z[3]); } }
#pragma unroll
                for (int m2 = 0; m2 < 2; ++m2) stat_store(s[m2], q[m2], ST, u.pm * 256 + ai * 128 + wr * 64 + (mh * 2 + m2) * 16 + fr, u.pn * 4 + wc, fq);
                asm volatile("" ::: "memory"); }
    }
};

__device__ __forceinline__ void first_seam(unsigned char* ws, LAS unsigned char* lds, bool leader) {
    volatile LAS unsigned* xst = (volatile LAS unsigned*)(lds + LDS_ST_OFF);
    if (leader) { xst[0] = 0u; xst[1] = 0u; }
    __syncthreads();
    (void)xcd_barrier_post((unsigned*)(ws + WS_BAR), xst, leader);
}
__device__ __forceinline__ void later_seam(unsigned char* ws, LAS unsigned char* lds, bool leader) {
    XcdBarrier xb; xb.bar = (unsigned*)(ws + WS_BAR); xb.x = xb_xcc_id(); xb.st = (volatile LAS unsigned*)(lds + LDS_ST_OFF);
    xcd_barrier(xb, leader);
}

__global__ void __launch_bounds__(512) mega(Params p) {
    extern __shared__ __attribute__((aligned(16))) unsigned char lds_raw[];
    LAS unsigned char* lds = (LAS unsigned char*)lds_raw;
    cg::grid_group grid = cg::this_grid();
    int ph = 0;
    const int wv_ = __builtin_amdgcn_readfirstlane((int)(threadIdx.x >> 6));
    if (blockIdx.x == 0) for (int i = threadIdx.x; i < XCD_BAR_WORDS; i += 512) ((unsigned*)(p.ws + WS_BAR))[i] = 0u;
#define PHASE_LOCALS const float* mod = (const float*)(p.ws + WS_MOD); float* Z = (float*)(p.ws + WS_Z); f32x2* ST = (f32x2*)(p.ws + WS_ST); bf16_t* Q = (bf16_t*)(p.ws + WS_Q); bf16_t* Hff = (bf16_t*)(p.ws + WS_Y); pg8::StaticOrder S; const float* lmod = mod + layer * 5 * 6144; (void)Z; (void)ST; (void)Q; (void)Hff; (void)lmod; (void)S
#define PHASE(kind, ...) do { if (ph >= p.ph_lo && ph < p.ph_hi) { for (int r_ = 0; r_ <= ((REPMASK >> (kind)) & 1); ++r_) { \
        { const Params& pp_ = p; { Params p = pp_; p.wv = wv_; asm volatile("" : "+s"(p.ws), "+s"(p.out), "+s"(p.wv)); PHASE_LOCALS; __VA_ARGS__; } } \
        if (ph + 1 < p.ph_hi || r_ < ((REPMASK >> (kind)) & 1)) { const bool leader_ = wv_ == 0 && lane_id_() == 0; if (ph == p.ph_lo && r_ == 0) { grid.sync(); first_seam(p.ws, lds, leader_); } else later_seam(p.ws, lds, leader_); } \
    } } ++ph; } while (0)
    { const int layer = 0; (void)layer;
    PHASE(0, phase_w0(p, lds));
    PHASE(1, phase_prep0(p)); }
    for (int layer_ = 0; layer_ < 4; ++layer_) {
        const int layer = opaque_s(layer_);
        const int jj = layer >> 1;
        if ((layer & 1) == 0) {
            PHASE(2, phase_s5(p, jj, 0, lds));
            PHASE(2, phase_s5(p, jj, 1, lds));
            PHASE(4, { pg8::Gemm g{Q, (const bf16_t*)(p.ws + WS_WG) + (size_t)jj * 2048 * 1024, NTOK, 2048, 1024, 1024, 0}; S.init(NTOK, 2048, gridDim.x, opaque_bid());
                    ResSrc R{layer == 0 ? p.in[0] : p.out, layer == 0 ? p.in[1] - (size_t)NCTX * D : p.out, layer == 0 ? nullptr : (const f32x2*)(p.ws + WS_MR2), p.in[8] + ((layer - 1) * 2 + 1) * 1024, p.in[9] + ((layer - 1) * 2 + 1) * 1024};
                    EpiGlu E{p.in[19] + jj * 2048, R, lmod, Z, ST};
                    pg8::gemm_phase(lds, g, S, E, p.wv); });
            PHASE(5, phase_ln(p, layer, 0, 32, 1));
        } else {
            PHASE(6, phase_poolprep(p, layer));
            PHASE(7, { pg8::Gemm g{Q, (const bf16_t*)(p.ws + WS_WP) + (size_t)jj * 4 * 65536, NTOK, 1024, 256, 1024, 256}; S.init(NTOK, 1024, gridDim.x, opaque_bid());
                    ResSrc R{p.out, p.out, (const f32x2*)(p.ws + WS_MR2), p.in[8] + ((layer - 1) * 2 + 1) * 1024, p.in[9] + ((layer - 1) * 2 + 1) * 1024};
                    EpiRes E{R, lmod, 2, p.in[21] + jj * 1024, Z, ST, (LAS float*)(lds + LDS_COL_OFF)};
                    pg8::gemm_phase(lds, g, S, E, p.wv); });
            PHASE(5, phase_ln(p, layer, 0, 16, 1));
        }
        PHASE(8, { pg8::Gemm g{Q, (const bf16_t*)(p.ws + WS_W1) + (size_t)layer * NFF1 * 1024, NTOK, NFF1, 1024, 1024, 0}; S.init(NTOK, NFF1, gridDim.x, opaque_bid());
                EpiFfn1 E{Hff}; pg8::gemm_phase(lds, g, S, E, p.wv); if (layer < 3) deferred_weights(p, lds, layer + 1, (NTOK / 256) * (NFF1 / 256)); });
        PHASE(9, { pg8::Gemm g{Hff, (const bf16_t*)(p.ws + WS_W2) + (size_t)layer * 1024 * DFF, NTOK, 1024, DFF, DFF, 0}; S.init(NTOK, 1024, gridDim.x, opaque_bid());
                ResSrc R{Z, Z, (const f32x2*)(p.ws + WS_MR1), p.in[8] + (layer * 2) * 1024, p.in[9] + (layer * 2) * 1024};
                EpiRes E{R, lmod, 5, nullptr, p.out, ST, (LAS float*)(lds + LDS_COL_OFF)}; pg8::gemm_phase(lds, g, S, E, p.wv); });
        PHASE(10, phase_ln(p, layer, 1, 16, layer == 3 ? 2 : (layer == 1 ? 1 : 0)));
    }
#undef PHASE
}

extern "C" void kernel_launch(void* const* d_in, const int* in_sizes, int n_in, void* d_out, int out_size, void* d_ws, size_t ws_size, hipStream_t stream) {
    static int grid_blocks = 0;
    if (grid_blocks == 0) {
        if (n_in != 25 || ws_size < WS_END) { fprintf(stderr, "kernel_launch: unexpected n_in %d or ws_size %zu (< %zu)\n", n_in, ws_size, (size_t)WS_END); grid_blocks = -1; return; }
        int dev = 0, cus = 0, per_cu = 0;
        hipGetDevice(&dev);
        hipDeviceGetAttribute(&cus, hipDeviceAttributeMultiprocessorCount, dev);
        if (hipFuncSetAttribute((const void*)mega, hipFuncAttributeMaxDynamicSharedMemorySize, LDS_BYTES) != hipSuccess) { fprintf(stderr, "kernel_launch: hipFuncSetAttribute failed\n"); grid_blocks = -1; return; }
        if (hipOccupancyMaxActiveBlocksPerMultiprocessor(&per_cu, (const void*)mega, 512, LDS_BYTES) != hipSuccess || per_cu < 1) { fprintf(stderr, "kernel_launch: occupancy query failed (%d)\n", per_cu); (void)hipGetLastError(); per_cu = 1; }
        if (per_cu > 1) per_cu = 1;
        grid_blocks = cus * per_cu;
    }
    if (grid_blocks < 0) return;
    Params p{};
    for (int i = 0; i < 25; ++i) p.in[i] = (const float*)d_in[i];
    p.out = (float*)d_out; p.ws = (unsigned char*)d_ws;
#if MULTI_LAUNCH
    for (int ph = 0; ph < NPH; ++ph) { p.ph_lo = ph; p.ph_hi = ph + 1; hipLaunchKernelGGL(mega, dim3(grid_blocks), dim3(512), LDS_BYTES, stream, p); }
#else
    p.ph_lo = 0; p.ph_hi = NPH;
    void* args[] = {&p};
    hipError_t e = hipLaunchCooperativeKernel((const void*)mega, dim3(grid_blocks), dim3(512), args, LDS_BYTES, stream);
    if (e != hipSuccess) fprintf(stderr, "cooperative launch failed: %s (grid %d)\n", hipGetErrorString(e), grid_blocks);
#endif
}
```

```cpp
#include <hip/hip_runtime.h>
#include <hip/hip_cooperative_groups.h>
#include <cstdio>
namespace cg = cooperative_groups;

#ifndef MULTI_LAUNCH
#define MULTI_LAUNCH 0
#endif
#ifndef REPMASK
#define REPMASK 0
#endif

#define LAS __attribute__((address_space(3)))
typedef unsigned short bf16_t;
typedef short bf16x8 __attribute__((ext_vector_type(8)));
typedef float f32x2 __attribute__((ext_vector_type(2)));
typedef float f32x4 __attribute__((ext_vector_type(4)));
typedef float f32x16 __attribute__((ext_vector_type(16)));
typedef unsigned u32x2 __attribute__((ext_vector_type(2)));
typedef unsigned u32x4 __attribute__((ext_vector_type(4)));

constexpr int D = 1024, NTOK = 16384, NCTX = 8192, DFF = 2816, NFF1 = 5632;
constexpr float ALPHA = 1.681792830507429f;
constexpr float LN_EPS = 1e-5f;
constexpr int LDS_BYTES = 131072 + 16 + 8 * 192 * 4;
constexpr int NPH = 28;
constexpr int XCD_BAR_WORDS_C = 3456;
constexpr int LDS_ST_OFF = 131072;
constexpr int LDS_COL_OFF = 131072 + 16;

constexpr size_t WS_W1 = 0;
constexpr size_t WS_W2 = WS_W1 + (size_t)4 * 5632 * 1024 * 2;
constexpr size_t WS_WG = WS_W2 + (size_t)4 * 1024 * 2816 * 2;
constexpr size_t WS_WP = WS_WG + (size_t)2 * 2048 * 1024 * 2;
constexpr size_t WS_MOD = WS_WP + (size_t)2 * 4 * 256 * 256 * 2;
constexpr size_t WS_ST = WS_MOD + (size_t)4 * 5 * 6144 * 4;
constexpr size_t WS_Z = WS_ST + (size_t)NTOK * 64 * 4;
constexpr size_t WS_Y = WS_Z + (size_t)NTOK * D * 4;
constexpr size_t WS_P = WS_Y + (size_t)2 * NTOK * D * 4;
constexpr size_t WS_Q = WS_P + (size_t)NTOK * D * 2;
constexpr size_t WS_BAR = WS_Q + (size_t)NTOK * D * 2;
constexpr size_t WS_E = WS_BAR + (size_t)XCD_BAR_WORDS_C * 4;
constexpr size_t WS_MR1 = WS_E + (size_t)32 * 2 * 64 * 64 * 8;
constexpr size_t WS_MR2 = WS_MR1 + (size_t)NTOK * 8;
constexpr size_t WS_END = WS_MR2 + (size_t)NTOK * 8;

struct Params {
    const float* in[25];
    float* out;
    unsigned char* ws;
    int ph_lo, ph_hi, wv, pad;
};

__device__ __forceinline__ unsigned cvt_pk_bf16(float lo, float hi) { unsigned r; asm("v_cvt_pk_bf16_f32 %0, %1, %2" : "=v"(r) : "v"(lo), "v"(hi)); return r; }
__device__ __forceinline__ float bf_lo(unsigned w) { return __uint_as_float(w << 16); }
__device__ __forceinline__ float bf_hi(unsigned w) { return __uint_as_float(w & 0xffff0000u); }
__device__ __forceinline__ float sigmoidf_(float x) { return __builtin_amdgcn_rcpf(1.0f + __expf(-x)); }
__device__ __forceinline__ float gelu_tanh(float x) { const float a = 1.5957691216057308f * (x + 0.044715f * x * x * x); return x * sigmoidf_(a); }
__device__ __forceinline__ int lane_id_() { int l; asm volatile("v_mbcnt_lo_u32_b32 %0, -1, 0\n\tv_mbcnt_hi_u32_b32 %0, -1, %0" : "=v"(l)); return l; }
__device__ __forceinline__ int opaque_tid(int wv) { int t = (wv << 6) | lane_id_(); asm volatile("" : "+v"(t)); return t; }
__device__ __forceinline__ int opaque_bid() { int b = blockIdx.x; asm volatile("" : "+s"(b)); return b; }
__device__ __forceinline__ int opaque_s(int v) { asm volatile("" : "+s"(v)); return v; }
__device__ __forceinline__ int cond_of_row(int row) { return row < NCTX ? 0 : 1 + ((row - NCTX) >> 11); }


#define XB_TMO      128
#define XB_XCNT(j)  (256  + 64 * (j))
#define XB_XSUB(j)  (1280 + 64 * (j))
#define XB_XGEN(j)  (2304 + 64 * (j))
#define XB_TOP      3328
#define XB_TOPGEN   3392
#define XCD_BAR_WORDS 3456
#define XB_SPIN_CAP (1u << 20)
__device__ __forceinline__ unsigned xb_ld(unsigned* p)              { return __hip_atomic_load(p, __ATOMIC_RELAXED, __HIP_MEMORY_SCOPE_AGENT); }
__device__ __forceinline__ unsigned xb_add(unsigned* p, unsigned v) { return __hip_atomic_fetch_add(p, v, __ATOMIC_RELAXED, __HIP_MEMORY_SCOPE_AGENT); }
__device__ __forceinline__ unsigned xb_xcc_id() { return (unsigned)__builtin_amdgcn_s_getreg((3 << 11) | 20) & 0xFu; }
#define XB_SPIN(cond, bar) do { unsigned _sp = 0; while (cond) { __builtin_amdgcn_s_sleep(1); \
    if ((++_sp & 255u) == 0u) { if (xb_ld(&(bar)[XB_TMO])) break; if (_sp > XB_SPIN_CAP) { atomicAdd(&(bar)[XB_TMO], 1u); break; } } } } while (0)
struct XcdBarrier { unsigned* bar; unsigned x; volatile LAS unsigned* st; };
__device__ __forceinline__ XcdBarrier xcd_barrier_post(unsigned* bar, volatile LAS unsigned* st, bool leader) {
    XcdBarrier b; b.bar = bar; b.x = xb_xcc_id(); b.st = st;
    if (leader) (void)xb_add(&bar[XB_XCNT(b.x)], 1u);
    return b;
}
__device__ __forceinline__ void xcd_barrier_complete(unsigned* bar, unsigned x, unsigned& nloc, unsigned& nx) {
    const unsigned G = gridDim.x * gridDim.y * gridDim.z;
    unsigned sum, cnt, mine, sp = 0u;
    for (;;) {
        sum = 0u; cnt = 0u; mine = 0u;
#pragma unroll
        for (unsigned j = 0; j < 16; ++j) { const unsigned c = xb_ld(&bar[XB_XCNT(j)]); sum += c; cnt += (c > 0u) ? 1u : 0u; mine = (j == x) ? c : mine; }
        if (sum == G) break;
        __builtin_amdgcn_s_sleep(1);
        if ((++sp & 255u) == 0u) { if (xb_ld(&bar[XB_TMO])) break; if (sp > XB_SPIN_CAP) { atomicAdd(&bar[XB_TMO], 1u); break; } }
    }
    nloc = mine > 0u ? mine : 1u; nx = cnt > 0u ? cnt : 1u;
}
__device__ __forceinline__ void xcd_barrier(const XcdBarrier& b, bool leader) {
    asm volatile("s_waitcnt vmcnt(0)" ::: "memory");
    __syncthreads();
    if (leader) {
        unsigned* bar = b.bar;
        __builtin_amdgcn_s_waitcnt(0);
        unsigned nloc = b.st[0], nx = b.st[1];
        if (nloc == 0u) { xcd_barrier_complete(bar, b.x, nloc, nx); b.st[0] = nloc; b.st[1] = nx; }
        const unsigned old = xb_add(&bar[XB_XSUB(b.x)], 1u);
        const unsigned gen = old / nloc;
        if (old + 1u == (gen + 1u) * nloc) {
            __builtin_amdgcn_fence(__ATOMIC_RELEASE, "agent");
            asm volatile("s_waitcnt vmcnt(0)" ::: "memory");
            const unsigned og = xb_add(&bar[XB_TOP], 1u);
            const unsigned tg = og / nx;
            if (og + 1u == (tg + 1u) * nx) xb_add(&bar[XB_TOPGEN], 1u);
            else XB_SPIN(xb_ld(&bar[XB_TOPGEN]) == tg, bar);
            __builtin_amdgcn_fence(__ATOMIC_ACQUIRE, "agent");
            xb_add(&bar[XB_XGEN(b.x)], 1u);
            asm volatile("s_waitcnt vmcnt(0)" ::: "memory");
        } else {
            XB_SPIN(xb_ld(&bar[XB_XGEN(b.x)]) == gen, bar);
            __builtin_amdgcn_fence(__ATOMIC_ACQUIRE, "agent");
            asm volatile("s_waitcnt vmcnt(0)" ::: "memory");
        }
    }
    __syncthreads();
}

__device__ __forceinline__ void adaln_item(const Params& p, int it, LAS float* lds) {
    const int tid = opaque_tid(p.wv);
    const int layer = it / 96, c0 = (it % 96) * 64;
    LAS float* s = lds;
    LAS float* red = lds + 5120;
    for (int e = tid; e < 5120; e += 512) { const int cnd = e >> 10, k = e & 1023; const float v = cnd == 0 ? p.in[5][k] : p.in[4][(cnd - 1) * 1024 + k]; s[e] = v * sigmoidf_(v); }
    __syncthreads();
    const int cgp = tid & 15, ks = tid >> 4;
    f32x4 acc[5];
#pragma unroll
    for (int c = 0; c < 5; ++c) acc[c] = (f32x4){0.f, 0.f, 0.f, 0.f};
    const float* base = p.in[6] + (size_t)layer * 1024 * 6144 + c0 + cgp * 4;
#pragma unroll 8
    for (int kk = 0; kk < 32; ++kk) { const int k = ks * 32 + kk; const f32x4 w = *(const f32x4*)(base + (size_t)k * 6144);
#pragma unroll
        for (int c = 0; c < 5; ++c) acc[c] += s[c * 1024 + k] * w; }
#pragma unroll
    for (int c = 0; c < 5; ++c) *(LAS f32x4*)(red + (ks * 5 + c) * 64 + cgp * 4) = acc[c];
    __syncthreads();
    if (tid < 320) { const int cnd = tid >> 6, col = tid & 63; float a = p.in[7][layer * 6144 + c0 + col];
        for (int k2 = 0; k2 < 32; ++k2) a += red[(k2 * 5 + cnd) * 64 + col];
        ((float*)(p.ws + WS_MOD))[(layer * 5 + cnd) * 6144 + c0 + col] = a; }
    __syncthreads();
}

struct TJob { const float* srcA; const float* srcB; bf16_t* dst; int src_ld, dst_ld, k0, c0; bool inter; };
struct WPtrs { const float* gate; const float* up; const float* down; const float* glu; const float* pool; unsigned char* ws; };
__device__ __forceinline__ TJob decode_job(const WPtrs& p, int idx) {
    TJob j;
    if (idx < 5632) { const int layer = idx / 1408, r = idx % 1408, kt = r / 88, ct = r % 88;
        j.srcA = p.gate + (size_t)layer * 1024 * 2816; j.srcB = p.up + (size_t)layer * 1024 * 2816; j.src_ld = 2816; j.k0 = kt * 64; j.c0 = ct * 64; j.inter = true; j.dst = (bf16_t*)(p.ws + WS_W1) + (size_t)layer * 5632 * 1024; j.dst_ld = 1024;
    } else if (idx < 8448) { const int r0 = idx - 5632, layer = r0 / 704, r = r0 % 704, kt = r / 16, ct = r % 16;
        j.srcA = p.down + (size_t)layer * 2816 * 1024; j.srcB = j.srcA; j.src_ld = 1024; j.k0 = kt * 64; j.c0 = ct * 64; j.inter = false; j.dst = (bf16_t*)(p.ws + WS_W2) + (size_t)layer * 1024 * 2816; j.dst_ld = 2816;
    } else if (idx < 9472) { const int r0 = idx - 8448, jj = r0 / 512, r = r0 % 512, kt = r / 32, ct = r % 32;
        j.srcA = p.glu + (size_t)jj * 1024 * 2048; j.srcB = j.srcA + 1024; j.src_ld = 2048; j.k0 = kt * 64; j.c0 = ct * 64; j.inter = true; j.dst = (bf16_t*)(p.ws + WS_WG) + (size_t)jj * 2048 * 1024; j.dst_ld = 1024;
    } else { const int r0 = idx - 9472, jg = r0 / 16, r = r0 % 16, kt = r / 4, ct = r % 4;
        j.srcA = p.pool + (size_t)jg * 65536; j.srcB = j.srcA; j.src_ld = 256; j.k0 = kt * 64; j.c0 = ct * 64; j.inter = false; j.dst = (bf16_t*)(p.ws + WS_WP) + (size_t)jg * 65536; j.dst_ld = 256; }
    return j;
}
__device__ __forceinline__ int job_idx(int list, int j) {
    if (list == 0) { if (j < 1408) return j; if (j < 2112) return 5632 + (j - 1408); if (j < 3136) return 8448 + (j - 2112); return 9472 + (j - 3136); }
    return j < 1408 ? list * 1408 + j : 5632 + list * 704 + (j - 1408);
}
__device__ __forceinline__ void transpose_list(const Params& pp, LAS float* lds, int list, int nj, int first, int stride) {
    const WPtrs p{pp.in[22], pp.in[23], pp.in[24], pp.in[18], pp.in[20], pp.ws};
    const int tid = opaque_tid(pp.wv), l64 = tid & 63, kk0 = tid >> 6, c = tid >> 3, ks = tid & 7;
    for (int base = first; base < nj; base += 4 * stride) {
        float vals[4][8]; int cl[4];
#pragma unroll
        for (int q = 0; q < 4; ++q) { const int jn = base + q * stride;
            if (jn < nj) { const TJob j = decode_job(p, job_idx(list, jn)); const float* sp;
                if (j.inter) { const int n = l64 >> 5, oo = l64 & 31; sp = (n ? j.srcB : j.srcA) + (j.c0 >> 1) + oo; cl[q] = (oo >> 4) * 32 + n * 16 + (oo & 15); }
                else { sp = j.srcA + j.c0 + l64; cl[q] = l64; }
#pragma unroll
                for (int i8 = 0; i8 < 8; ++i8) vals[q][i8] = sp[(size_t)(j.k0 + kk0 + i8 * 8) * j.src_ld]; } }
#pragma unroll
        for (int q = 0; q < 4; ++q) { if (base + q * stride < nj) {
#pragma unroll
                for (int i8 = 0; i8 < 8; ++i8) lds[q * 4160 + (kk0 + i8 * 8) * 65 + cl[q]] = vals[q][i8]; } }
        __syncthreads();
#pragma unroll
        for (int q = 0; q < 4; ++q) { const int jn = base + q * stride;
            if (jn < nj) { const TJob j = decode_job(p, job_idx(list, jn)); float v[8];
#pragma unroll
                for (int e = 0; e < 8; ++e) v[e] = lds[q * 4160 + (ks * 8 + e) * 65 + c];
                u32x4 w; w.x = cvt_pk_bf16(v[0], v[1]); w.y = cvt_pk_bf16(v[2], v[3]); w.z = cvt_pk_bf16(v[4], v[5]); w.w = cvt_pk_bf16(v[6], v[7]);
                *(u32x4*)(j.dst + (size_t)(j.c0 + c) * j.dst_ld + j.k0 + ks * 8) = w; } }
        __syncthreads();
    }
}
__device__ __forceinline__ void phase_w0(const Params& p, LAS unsigned char* lds8) {
    LAS float* lds = (LAS float*)lds8;
    const int NADA = 384, G = gridDim.x;
    const int bid = opaque_bid();
    for (int it = bid; it < NADA; it += G) adaln_item(p, it, lds);
    transpose_list(p, lds, 0, 3264, bid, G);
}
__device__ __forceinline__ void deferred_weights(const Params& p, LAS unsigned char* lds8, int list, int nunits) {
    const int G = gridDim.x, rem = nunits % G, c = opaque_bid();
    if (rem == 0) transpose_list(p, (LAS float*)lds8, list, 2112, c, G);
    else if (c >= rem) transpose_list(p, (LAS float*)lds8, list, 2112, c - rem, G - rem);
}

__device__ __forceinline__ void store_bf16x8(bf16_t* dst, const f32x4 a, const f32x4 b) {
    u32x4 w; w.x = cvt_pk_bf16(a[0], a[1]); w.y = cvt_pk_bf16(a[2], a[3]); w.z = cvt_pk_bf16(b[0], b[1]); w.w = cvt_pk_bf16(b[2], b[3]);
    *(u32x4*)dst = w;
}

__device__ __forceinline__ void phase_prep0(const Params& p) {
    const int tid_ = opaque_tid(p.wv), bid_ = opaque_bid(); const int wid = tid_ >> 6, lane = tid_ & 63;
    const float* mod = (const float*)(p.ws + WS_MOD);
    bf16_t* P = (bf16_t*)(p.ws + WS_P);
    for (int g4 = bid_ * 8 + wid; g4 < NTOK / 4; g4 += gridDim.x * 8) {
        const int row0 = g4 * 4; const int cnd = cond_of_row(row0);
        const float* src = row0 < NCTX ? p.in[0] + (size_t)row0 * D : p.in[1] + (size_t)(row0 - NCTX) * D;
        const float* sh = mod + (0 * 5 + cnd) * 6144, *sc = sh + 1024;
        f32x4 x[4][2][2];
#pragma unroll
        for (int r = 0; r < 4; ++r)
#pragma unroll
            for (int j = 0; j < 2; ++j) { const int col = j * 512 + lane * 8; x[r][j][0] = *(const f32x4*)(src + r * D + col); x[r][j][1] = *(const f32x4*)(src + r * D + col + 4); }
#pragma unroll
        for (int j = 0; j < 2; ++j) { const int col = j * 512 + lane * 8;
            const f32x4 s0 = 1.0f + *(const f32x4*)(sc + col), s1 = 1.0f + *(const f32x4*)(sc + col + 4), b0 = *(const f32x4*)(sh + col), b1 = *(const f32x4*)(sh + col + 4);
#pragma unroll
            for (int r = 0; r < 4; ++r) store_bf16x8(P + (size_t)(row0 + r) * D + col, x[r][j][0] * s0 + b0, x[r][j][1] * s1 + b1); }
    }
}

__device__ __forceinline__ void phase_ln(const Params& p, int layer, int which, int npart, int mode) {
    const int tid_ = opaque_tid(p.wv), bid_ = opaque_bid(); const int wid = tid_ >> 6, lane = tid_ & 63;
    const float* mod = (const float*)(p.ws + WS_MOD);
    float* Z = which == 0 ? (float*)(p.ws + WS_Z) : p.out;
    const f32x2* ST = (const f32x2*)(p.ws + WS_ST);
    f32x2* MR = (f32x2*)(p.ws + (which == 0 ? WS_MR1 : WS_MR2));
    const float* lg = p.in[8] + (layer * 2 + which) * 1024, *lb = p.in[9] + (layer * 2 + which) * 1024;
    const bool rdz = which == 0 || mode != 0;
    for (int g4 = bid_ * 8 + wid; g4 < NTOK / 4; g4 += gridDim.x * 8) {
        const int row0 = g4 * 4;
        f32x2 st[4]; f32x4 z[4][2][2];
#pragma unroll
        for (int r = 0; r < 4; ++r) { st[r] = lane < npart ? ST[(size_t)(row0 + r) * 32 + lane] : (f32x2){0.f, 0.f};
            if (rdz) {
#pragma unroll
                for (int j = 0; j < 2; ++j) { const size_t off = (size_t)(row0 + r) * D + j * 512 + lane * 8; z[r][j][0] = *(const f32x4*)(Z + off); z[r][j][1] = *(const f32x4*)(Z + off + 4); } } }
        float mean[4], rstd[4];
#pragma unroll
        for (int r = 0; r < 4; ++r) {
#pragma unroll
            for (int o = 1; o < 64; o <<= 1) { st[r].x += __shfl_xor(st[r].x, o); st[r].y += __shfl_xor(st[r].y, o); }
            mean[r] = st[r].x * (1.0f / 1024.0f); const float var = fmaxf(st[r].y * (1.0f / 1024.0f) - mean[r] * mean[r], 0.f); rstd[r] = rsqrtf(var + LN_EPS); }
        if (lane < 4) { const int r = lane; const float m_ = r == 0 ? mean[0] : r == 1 ? mean[1] : r == 2 ? mean[2] : mean[3]; const float s_ = r == 0 ? rstd[0] : r == 1 ? rstd[1] : r == 2 ? rstd[2] : rstd[3]; MR[row0 + r] = (f32x2){m_, s_}; }
        if (!rdz) continue;
        const int cnd = cond_of_row(row0);
        const float* sh = nullptr; const float* sc = nullptr; bf16_t* dst = nullptr;
        if (which == 0) { sh = mod + (layer * 5 + cnd) * 6144 + 3 * 1024; sc = sh + 1024; dst = (bf16_t*)(p.ws + WS_Q); }
        else if (mode == 1) { sh = mod + ((layer + 1) * 5 + cnd) * 6144; sc = sh + 1024; dst = (bf16_t*)(p.ws + WS_P); }
#pragma unroll
        for (int j = 0; j < 2; ++j) { const int col = j * 512 + lane * 8;
            const f32x4 g0 = *(const f32x4*)(lg + col), g1 = *(const f32x4*)(lg + col + 4), b0 = *(const f32x4*)(lb + col), b1 = *(const f32x4*)(lb + col + 4);
            f32x4 s0 = {0.f, 0.f, 0.f, 0.f}, s1 = s0, h0 = s0, h1 = s0;
            if (dst) { s0 = 1.0f + *(const f32x4*)(sc + col); s1 = 1.0f + *(const f32x4*)(sc + col + 4); h0 = *(const f32x4*)(sh + col); h1 = *(const f32x4*)(sh + col + 4); }
#pragma unroll
            for (int r = 0; r < 4; ++r) { const size_t off = (size_t)(row0 + r) * D + col;
                const f32x4 x0 = (z[r][j][0] - mean[r]) * rstd[r] * g0 + b0, x1 = (z[r][j][1] - mean[r]) * rstd[r] * g1 + b1;
                if (dst) store_bf16x8(dst + off, x0 * s0 + h0, x1 * s1 + h1);
                else { *(f32x4*)(Z + off) = x0; *(f32x4*)(Z + off + 4) = x1; } } }
    }
}

__device__ __forceinline__ void phase_comb(const Params& p, int jj) {
    const int tid_ = opaque_tid(p.wv), bid_ = opaque_bid(); const int wid = tid_ >> 6, lane = tid_ & 63;
    const bf16_t* P = (const bf16_t*)(p.ws + WS_P);
    const float* YF = (const float*)(p.ws + WS_Y), *YB = YF + (size_t)NTOK * D;
    bf16_t* Q = (bf16_t*)(p.ws + WS_Q);
    const float* dsk = p.in[17] + jj * 1024;
    for (int g2 = bid_ * 8 + wid; g2 < NTOK / 2; g2 += gridDim.x * 8) {
        const int row0 = g2 * 2;
        u32x4 uw[2][2]; f32x4 yf[2][2][2], yb[2][2][2];
#pragma unroll
        for (int r = 0; r < 2; ++r)
#pragma unroll
            for (int j = 0; j < 2; ++j) { const size_t off = (size_t)(row0 + r) * D + j * 512 + lane * 8;
                uw[r][j] = *(const u32x4*)(P + off); yf[r][j][0] = *(const f32x4*)(YF + off); yf[r][j][1] = *(const f32x4*)(YF + off + 4); yb[r][j][0] = *(const f32x4*)(YB + off); yb[r][j][1] = *(const f32x4*)(YB + off + 4); }
#pragma unroll
        for (int j = 0; j < 2; ++j) { const int col = j * 512 + lane * 8; const f32x4 d0 = *(const f32x4*)(dsk + col), d1 = *(const f32x4*)(dsk + col + 4);
#pragma unroll
            for (int r = 0; r < 2; ++r) { const u32x4 w = uw[r][j];
                const f32x4 u0 = {bf_lo(w.x), bf_hi(w.x), bf_lo(w.y), bf_hi(w.y)}, u1 = {bf_lo(w.z), bf_hi(w.z), bf_lo(w.w), bf_hi(w.w)};
                f32x4 y0 = u0 * d0 + yf[r][j][0] + yb[r][j][0], y1 = u1 * d1 + yf[r][j][1] + yb[r][j][1];
#pragma unroll
                for (int e = 0; e < 4; ++e) { y0[e] = gelu_tanh(y0[e]); y1[e] = gelu_tanh(y1[e]); }
                store_bf16x8(Q + (size_t)(row0 + r) * D + col, y0, y1); } }
    }
}

template <int K> __device__ __forceinline__ void pool2d_task(const float* X, const f32x2* MR, const float* lg, const float* mod, bf16_t* Q, int layer, int b, int c, int ch, int lane) {
    const int clo = max(c - K / 2, 0), chi = min(c - K / 2 + K, 64);
    const size_t tb = (size_t)(NCTX + b * 2048);
    f32x2 hs[32];
    constexpr int RB = 32 / K;
    const float* xb = X + (tb + clo) * D + ch; const f32x2* mb = MR + tb + clo;
    const int nc = chi - clo;
    const int jl = lane & 31, jr = jl / K, ji = (jl % K) < nc ? (jl % K) : nc - 1;
#pragma clang loop unroll(full)
    for (int rb = 0; rb < K; ++rb) {
        f32x2 t_[32];
        const f32x2 mv = mb[(rb * RB + jr) * 64 + ji];
#pragma clang loop unroll(full)
        for (int j = 0; j < 32; ++j) { const int rr = j / K, i = j % K; const int r = rb * RB + rr; const int ic = i < nc ? i : nc - 1;
            t_[j] = *(const f32x2*)(xb + ((size_t)r * 64 + ic) * D); }
#pragma clang loop unroll(full)
        for (int rr = 0; rr < RB; ++rr) { f32x2 a = {0.f, 0.f};
#pragma clang loop unroll(full)
            for (int i = 0; i < K; ++i) { const int j = rr * K + i;
                const float mx = __int_as_float(__builtin_amdgcn_readlane(__float_as_int(mv.x), j)), my = __int_as_float(__builtin_amdgcn_readlane(__float_as_int(mv.y), j));
                a += (t_[j] - mx) * (i < nc ? my : 0.0f); }
            hs[rb * RB + rr] = a; } }
    const f32x2 sc = (1.0f + *(const f32x2*)(mod + (layer * 5 + 1 + b) * 6144 + 1024 + ch)) * *(const f32x2*)(lg + ch);
#pragma unroll
    for (int rb = 0; rb < 2; ++rb) {
        f32x2 xcv[16], mrv[16];
#pragma unroll
        for (int i = 0; i < 16; ++i) { const int r = rb * 16 + i; xcv[i] = *(const f32x2*)(X + (tb + r * 64 + c) * D + ch); mrv[i] = MR[tb + r * 64 + c]; }
#pragma unroll
        for (int i = 0; i < 16; ++i) { const int r = rb * 16 + i; const int rlo = (r - K / 2) < 0 ? 0 : (r - K / 2), rhi = (r - K / 2 + K) > 32 ? 32 : (r - K / 2 + K);
            f32x2 t = {0.f, 0.f};
#pragma unroll
            for (int rr = rlo; rr < rhi; ++rr) t += hs[rr];
            const float inv = 1.0f / (float)((rhi - rlo) * (chi - clo));
            const f32x2 xc = (xcv[i] - mrv[i].x) * mrv[i].y;
            const f32x2 o = (t * inv - xc) * sc;
            *(unsigned*)(Q + (tb + r * 64 + c) * D + ch) = cvt_pk_bf16(o.x, o.y); }
        asm volatile("" ::: "memory"); }
}
template <int K> __device__ __forceinline__ void pool1d_task(const float* X, const f32x2* MR, const float* lg, const float* mod, bf16_t* Q, int layer, int b, int t0, int ch) {
    const size_t tb = (size_t)b * 256;
    f32x2 v[16 + K];
#pragma unroll
    for (int i = 0; i < 16 + K; ++i) { const int t = t0 - K / 2 + i;
        if (t >= 0 && t < 256) { const f32x2 mr = MR[tb + t]; v[i] = (*(const f32x2*)(X + (tb + t) * D + ch) - mr.x) * mr.y; } else v[i] = (f32x2){0.f, 0.f}; }
    const f32x2 sc = (1.0f + *(const f32x2*)(mod + (layer * 5 + 0) * 6144 + 1024 + ch)) * *(const f32x2*)(lg + ch);
#pragma unroll
    for (int i = 0; i < 16; ++i) { const int t = t0 + i; const int lo = max(t - K / 2, 0), hi = min(t - K / 2 + K, 256);
        f32x2 s2 = {0.f, 0.f};
#pragma unroll
        for (int k2 = 0; k2 < K; ++k2) s2 += v[i + k2];
        const float inv = 1.0f / (float)(hi - lo);
        const f32x2 o = (s2 * inv - v[i + K / 2]) * sc;
        *(unsigned*)(Q + (tb + t) * D + ch) = cvt_pk_bf16(o.x, o.y); }
}
__device__ __forceinline__ void phase_poolprep(const Params& p, int layer) {
    const int tid_ = opaque_tid(p.wv), bid_ = opaque_bid(); const int wid = tid_ >> 6, lane = tid_ & 63;
    const float* X = p.out; const float* mod = (const float*)(p.ws + WS_MOD); bf16_t* Q = (bf16_t*)(p.ws + WS_Q);
    const f32x2* MR = (const f32x2*)(p.ws + WS_MR2); const float* lg = p.in[8] + ((layer - 1) * 2 + 1) * 1024;
    const int nslots = gridDim.x * 8;
    for (int t = wid * gridDim.x + bid_; t < 2048 + 4096; t += nslots) {
        if (t < 2048) { const int gi = 3 - (t >> 9), r = t & 511, b = r >> 7, c = (r >> 1) & 63, half = r & 1; const int ch = gi * 256 + half * 128 + lane * 2;
            if (gi == 3) pool2d_task<16>(X, MR, lg, mod, Q, layer, b, c, ch, lane); else if (gi == 2) pool2d_task<8>(X, MR, lg, mod, Q, layer, b, c, ch, lane);
            else if (gi == 1) pool2d_task<4>(X, MR, lg, mod, Q, layer, b, c, ch, lane); else pool2d_task<2>(X, MR, lg, mod, Q, layer, b, c, ch, lane);
        } else { const int u = t - 2048; const int gi = 3 - (u >> 10), r = u & 1023, b = r >> 5, seg = (r >> 1) & 15, half = r & 1; const int ch = gi * 256 + half * 128 + lane * 2;
            if (gi == 3) pool1d_task<16>(X, MR, lg, mod, Q, layer, b, seg * 16, ch); else if (gi == 2) pool1d_task<8>(X, MR, lg, mod, Q, layer, b, seg * 16, ch);
            else if (gi == 1) pool1d_task<4>(X, MR, lg, mod, Q, layer, b, seg * 16, ch); else pool1d_task<2>(X, MR, lg, mod, Q, layer, b, seg * 16, ch);
        }
    }
}

constexpr int S5_ROWB = 272;
constexpr int S5_WAVE_LDS = 32 * S5_ROWB;

template <int MODE>
__device__ __forceinline__ void s5_task(const Params& p, int jj, int task, LAS unsigned char* wl, int lane) {
    const int pair = task >> 7, dir = (task >> 6) & 1, g = task & 63;
    constexpr int L = 256, ntile = 16;
    const int half = lane >> 5, p0 = lane & 31;
    const int pidx = (jj * 2 + dir) * 64 + g;
    const float dt = expf(p.in[12][pidx]);
    float ar[2], ai[2]; bf16x8 Bre[2], Bim[2];
#pragma unroll
    for (int s = 0; s < 2; ++s) { const int P = p0 + 32 * s;
        const float are = p.in[10][pidx * 64 + P], aim = p.in[11][pidx * 64 + P];
        const float mag = expf(are * dt), ang = aim * dt; float sn, cs; sn = sinf(ang); cs = cosf(ang);
        const float abr = mag * cs, abi = mag * sn, den = are * are + aim * aim, nr = abr - 1.0f;
        const float cr = (nr * are + abi * aim) / den, ci = (abi * are - nr * aim) / den;
        const float* br = p.in[13] + ((size_t)(pidx * 64 + P) * 16 + half * 8), *bi = p.in[14] + ((size_t)(pidx * 64 + P) * 16 + half * 8);
        const f32x4 br0 = *(const f32x4*)br, br1 = *(const f32x4*)(br + 4), bi0 = *(const f32x4*)bi, bi1 = *(const f32x4*)(bi + 4);
        const f32x4 r0 = cr * br0 - ci * bi0, r1 = cr * br1 - ci * bi1, i0 = cr * bi0 + ci * br0, i1 = cr * bi1 + ci * br1;
        u32x4 wr_, wi_;
        wr_.x = cvt_pk_bf16(r0[0], r0[1]); wr_.y = cvt_pk_bf16(r0[2], r0[3]); wr_.z = cvt_pk_bf16(r1[0], r1[1]); wr_.w = cvt_pk_bf16(r1[2], r1[3]);
        wi_.x = cvt_pk_bf16(i0[0], i0[1]); wi_.y = cvt_pk_bf16(i0[2], i0[3]); wi_.z = cvt_pk_bf16(i1[0], i1[1]); wi_.w = cvt_pk_bf16(i1[2], i1[3]);
        Bre[s] = __builtin_bit_cast(bf16x8, wr_); Bim[s] = __builtin_bit_cast(bf16x8, wi_);
        ar[s] = abr; ai[s] = abi; }
    const int csc = pair * 2 + half;
    f32x2* E = (f32x2*)(p.ws + WS_E);
    float sr[2], si[2];
#pragma unroll
    for (int s = 0; s < 2; ++s) { sr[s] = 0.f; si[s] = 0.f; }
    if (MODE == 2) {
        const int b = csc >> 3, k = csc & 7;
#pragma unroll
        for (int s = 0; s < 2; ++s) { const int P = p0 + 32 * s;
            float qr = ar[s], qi = ai[s];
#pragma unroll
            for (int e = 0; e < 8; ++e) { const float t = qr * qr - qi * qi; qi = 2.0f * qr * qi; qr = t; }
            const size_t ix = ((size_t)((b * 2 + jj) * 2 + dir) * 64 + g) * 64 + P;
            float hr = p.in[2][ix], hi = p.in[3][ix];
            for (int e = 0; e < 7; ++e) { const int kk = dir ? 7 - e : e;
                const bool pre = dir ? (kk > k) : (kk < k);
                const f32x2 ev = E[((size_t)((b * 8 + kk) * 2 + dir) * 64 + g) * 64 + P];
                if (pre) { const float t = qr * hr - qi * hi + ev.x; hi = qr * hi + qi * hr + ev.y; hr = t; } }
            sr[s] = hr; si[s] = hi; }
    }
    bf16x8 Cop[4];
    if (MODE != 1) { const int n = lane & 15, kq = lane >> 4;
#pragma unroll
      for (int ks = 0; ks < 4; ++ks) { const int pp = ks * 16 + kq * 4;
          const f32x4 cre = *(const f32x4*)(p.in[15] + ((size_t)(pidx * 16 + n) * 64 + pp)), cim = *(const f32x4*)(p.in[16] + ((size_t)(pidx * 16 + n) * 64 + pp));
          u32x4 w; w.x = cvt_pk_bf16(cre[0], -cim[0]); w.y = cvt_pk_bf16(cre[1], -cim[1]); w.z = cvt_pk_bf16(cre[2], -cim[2]); w.w = cvt_pk_bf16(cre[3], -cim[3]);
          Cop[ks] = __builtin_bit_cast(bf16x8, w); } }
    const int m = lane & 31, lc = (m >> 2) & 1, ltau = ((m >> 3) << 2) | (m & 3), kh = lane >> 5;
    const int lch = pair * 2 + lc; const int lbase = MODE == 0 ? lch * 256 : NCTX + lch * 256;
    const bf16_t* Pu = (const bf16_t*)(p.ws + WS_P) + g * 16 + kh * 8;
    float* Yd = (float*)(p.ws + WS_Y) + (size_t)dir * NTOK * D + g * 16 + (lane >> 4) * 4;
    const int otau = lane & 15;
    auto tok_of = [&](int base, int ti, int tau) { const int step = ti * 16 + tau; return base + (dir ? (L - 1 - step) : step); };
    bf16x8 u0 = *(const bf16x8*)(Pu + (size_t)tok_of(lbase, 0, ltau) * D);
    bf16x8 u1 = *(const bf16x8*)(Pu + (size_t)tok_of(lbase, 1, ltau) * D);
    const f32x16 zero16 = {0.f, 0.f, 0.f, 0.f, 0.f, 0.f, 0.f, 0.f, 0.f, 0.f, 0.f, 0.f, 0.f, 0.f, 0.f, 0.f};
    for (int ti = 0; ti < ntile; ++ti) {
        const int tn = min(ti + 2, ntile - 1);
        const bf16x8 u2 = *(const bf16x8*)(Pu + (size_t)tok_of(lbase, tn, ltau) * D);
        f32x16 dre[2], dim_[2];
        asm volatile("s_nop 4\n\t"
                     "v_mfma_f32_32x32x16_bf16 %0, %4, %5, 0\n\t"
                     "v_mfma_f32_32x32x16_bf16 %1, %4, %6, 0\n\t"
                     "v_mfma_f32_32x32x16_bf16 %2, %4, %7, 0\n\t"
                     "v_mfma_f32_32x32x16_bf16 %3, %4, %8, 0\n\t"
                     "s_nop 15\n\ts_nop 15\n\ts_nop 7"
                     : "=&v"(dre[0]), "=&v"(dim_[0]), "=&v"(dre[1]), "=&v"(dim_[1])
                     : "v"(u0), "v"(Bre[0]), "v"(Bim[0]), "v"(Bre[1]), "v"(Bim[1]));
        float x0r = sr[0], x0i = si[0], x1r = sr[1], x1i = si[1];
#pragma unroll
        for (int i = 0; i < 16; ++i) {
            const float n0r = fmaf(ar[0], x0r, fmaf(-ai[0], x0i, dre[0][i])), n0i = fmaf(ar[0], x0i, fmaf(ai[0], x0r, dim_[0][i]));
            const float n1r = fmaf(ar[1], x1r, fmaf(-ai[1], x1i, dre[1][i])), n1i = fmaf(ar[1], x1i, fmaf(ai[1], x1r, dim_[1][i]));
            x0r = n0r; x0i = n0i; x1r = n1r; x1i = n1i;
            if (MODE != 1) { *(LAS unsigned*)(wl + (half * 16 + i) * S5_ROWB + p0 * 4) = cvt_pk_bf16(x0r, x0i);
                             *(LAS unsigned*)(wl + (half * 16 + i) * S5_ROWB + (p0 + 32) * 4) = cvt_pk_bf16(x1r, x1i); }
        }
        sr[0] = x0r; si[0] = x0i; sr[1] = x1r; si[1] = x1i;
        if (MODE != 1) {
            asm volatile("s_waitcnt lgkmcnt(0)" ::: "memory");
            __builtin_amdgcn_wave_barrier();
#pragma unroll
            for (int c = 0; c < 2; ++c) { f32x4 acc = {0.f, 0.f, 0.f, 0.f};
#pragma unroll
                for (int ks = 0; ks < 4; ++ks) { const bf16x8 sf = *(const LAS bf16x8*)(wl + (c * 16 + otau) * S5_ROWB + ks * 64 + (lane >> 4) * 16);
                    acc = __builtin_amdgcn_mfma_f32_16x16x32_bf16(Cop[ks], sf, acc, 0, 0, 0); }
                const int och = pair * 2 + c; const int obase = MODE == 0 ? och * 256 : NCTX + och * 256;
                *(f32x4*)(Yd + (size_t)tok_of(obase, ti, otau) * D) = acc; }
            asm volatile("s_waitcnt lgkmcnt(0)" ::: "memory");
            __builtin_amdgcn_wave_barrier();
        }
        u0 = u1; u1 = u2;
    }
    if (MODE == 0) { float* ore = p.out + (size_t)NTOK * D, *oim = ore + 32 * 2 * 2 * 64 * 64;
#pragma unroll
        for (int s = 0; s < 2; ++s) { const size_t ix = ((size_t)((csc * 2 + jj) * 2 + dir) * 64 + g) * 64 + p0 + 32 * s; ore[ix] = sr[s]; oim[ix] = si[s]; } }
    if (MODE == 1) {
#pragma unroll
        for (int s = 0; s < 2; ++s) E[((size_t)(csc * 2 + dir) * 64 + g) * 64 + p0 + 32 * s] = (f32x2){sr[s], si[s]}; }
}

__device__ __forceinline__ void s5_combine(const Params& p, int jj, bool lat, int idx, int c, int lane) {
    const int pair = idx >> 6, g = idx & 63, seq = pair * 2 + c; const int base = lat ? NCTX + seq * 256 : seq * 256;
    const bf16_t* P = (const bf16_t*)(p.ws + WS_P);
    const float* YF = (const float*)(p.ws + WS_Y), *YB = YF + (size_t)NTOK * D;
    bf16_t* Q = (bf16_t*)(p.ws + WS_Q);
    const float* dsk = p.in[17] + jj * 1024 + g * 16;
    const f32x4 d0 = *(const f32x4*)dsk, d1 = *(const f32x4*)(dsk + 4), d2 = *(const f32x4*)(dsk + 8), d3 = *(const f32x4*)(dsk + 12);
#pragma unroll
    for (int jp = 0; jp < 2; ++jp) {
        u32x4 uw[2][2]; f32x4 yf[2][4], yb[2][4];
#pragma unroll
        for (int r = 0; r < 2; ++r) { const size_t off = (size_t)(base + lane + 64 * (jp * 2 + r)) * D + g * 16;
            uw[r][0] = *(const u32x4*)(P + off); uw[r][1] = *(const u32x4*)(P + off + 8);
#pragma unroll
            for (int e = 0; e < 4; ++e) { yf[r][e] = *(const f32x4*)(YF + off + 4 * e); yb[r][e] = *(const f32x4*)(YB + off + 4 * e); } }
#pragma unroll
        for (int r = 0; r < 2; ++r) { const size_t off = (size_t)(base + lane + 64 * (jp * 2 + r)) * D + g * 16;
            const u32x4 w0 = uw[r][0], w1 = uw[r][1];
            f32x4 y0 = (f32x4){bf_lo(w0.x), bf_hi(w0.x), bf_lo(w0.y), bf_hi(w0.y)} * d0 + yf[r][0] + yb[r][0];
            f32x4 y1 = (f32x4){bf_lo(w0.z), bf_hi(w0.z), bf_lo(w0.w), bf_hi(w0.w)} * d1 + yf[r][1] + yb[r][1];
            f32x4 y2 = (f32x4){bf_lo(w1.x), bf_hi(w1.x), bf_lo(w1.y), bf_hi(w1.y)} * d2 + yf[r][2] + yb[r][2];
            f32x4 y3 = (f32x4){bf_lo(w1.z), bf_hi(w1.z), bf_lo(w1.w), bf_hi(w1.w)} * d3 + yf[r][3] + yb[r][3];
#pragma unroll
            for (int e = 0; e < 4; ++e) { y0[e] = gelu_tanh(y0[e]); y1[e] = gelu_tanh(y1[e]); y2[e] = gelu_tanh(y2[e]); y3[e] = gelu_tanh(y3[e]); }
            store_bf16x8(Q + off, y0, y1); store_bf16x8(Q + off + 8, y2, y3); }
    }
}

__device__ __forceinline__ void phase_s5(const Params& p, int jj, int sub, LAS unsigned char* lds) {
    const int tid_ = opaque_tid(p.wv), bid_ = opaque_bid(); const int wid = tid_ >> 6, lane = tid_ & 63;
    const int G = gridDim.x, nslots = G * 8, slot = wid * G + bid_;
    LAS unsigned char* wl = lds + wid * S5_WAVE_LDS;
    if (sub == 0) { for (int t = slot; t < 2048; t += nslots) s5_task<1>(p, jj, t, wl, lane); }
    for (int b4 = bid_; b4 < 256; b4 += G) {
        const int idx = b4 * 4 + (wid >> 1); const int task = ((idx >> 6) << 7) | ((wid & 1) << 6) | (idx & 63);
        if (sub == 0) s5_task<0>(p, jj, task, wl, lane); else s5_task<2>(p, jj, task, wl, lane);
        __syncthreads();
        s5_combine(p, jj, sub != 0, idx, wid & 1, lane);
    }
}

namespace pg8 {
constexpr int BM = 256, BK = 64, HALF = 128, HTB = HALF * BK * 2, NXCD = 8, WGM = 8;
__device__ __forceinline__ int lds_byte(int r, int c) { const int st = (r >> 4) * 2 + (c >> 5), rr = r & 15, cc = c & 31, ob = rr * 64 + cc * 2; return st * 1024 + (ob ^ (((ob >> 9) & 1) << 5)); }
__device__ __forceinline__ void stage_rc(int b, int& R, int& C) { const int st = b / 1024, sb = b % 1024, swz = sb ^ (((sb >> 9) & 1) << 5); R = (st >> 1) * 16 + swz / 64; C = (st & 1) * 32 + (swz % 64) / 2; }
struct Unit { int pm, pn; };
struct Gemm { const bf16_t* A; const bf16_t* Bt; int M, N, K, lda, acol; };
struct StaticOrder {
    int nM, nN, nwg, G, c;
    __device__ void init(int M, int N, int G_, int c_) { nM = M / BM; nN = N / BM; nwg = nM * nN; G = G_; c = c_; }
    __device__ bool next(int i, Unit& u) const {
        const long L = (long)i * G + c; if (L >= nwg) return false;
        int wgid = (int)L; { const int q = nwg / NXCD, r = nwg % NXCD, xcd = wgid % NXCD, off = wgid / NXCD; wgid = (xcd < r ? xcd * (q + 1) : r * (q + 1) + (xcd - r) * q) + off; }
        const int nig = WGM * nN, gid = wgid / nig, fm = gid * WGM, gsz = (nM - fm) < WGM ? (nM - fm) : WGM;
        u.pm = fm + ((wgid % nig) % gsz); u.pn = (wgid % nig) / gsz; return true;
    }
};

template <class Epi>
__device__ __forceinline__ void gemm_phase(LAS unsigned char* lds, const Gemm g, const StaticOrder& S, const Epi& E, int wv) {
    const int tid = opaque_tid(wv), wid = __builtin_amdgcn_readfirstlane(tid >> 6), lane = tid & 63, wr = wid >> 2, wc = wid & 3, fr = lane & 15, fq = lane >> 4;
    const int K = g.K, nt = K / BK, lda = g.lda;
    unsigned voffA[2], voffB[2];
#pragma unroll
    for (int i = 0; i < 2; ++i) { int R, C; stage_rc(tid * 16 + i * 8192, R, C); voffA[i] = (unsigned)(R * lda + C) * 2u; voffB[i] = (unsigned)(R * K + C) * 2u; }
    const size_t kstep = (size_t)(BK * 2);
    const size_t hstepA = (size_t)HALF * lda * 2, hstepB = (size_t)HALF * K * 2;
    const size_t tstepA = 2 * hstepA, tstepB = 2 * hstepB;
    const size_t acolb = (size_t)g.acol * 2;
    const unsigned ldsw = (unsigned)wid * 1024u;
    const int aoff = lds_byte(wr * 64 + fr, fq * 8), boff = lds_byte(wc * 32 + fr, fq * 8);
#define PG8_SA(b, h) (((b) * 2 + (h)) * HTB)
#define PG8_SB(b, h) ((4 + (b) * 2 + (h)) * HTB)
#define PG8_STAGE(bufoff, gbase, voff) do { _Pragma("unroll") for (int _i = 0; _i < 2; ++_i) \
        __builtin_amdgcn_global_load_lds((const unsigned*)((const char*)(gbase) + (voff)[_i]), (LAS unsigned*)(lds + (bufoff) + ldsw + _i * 8192), 16, 0, 0); } while (0)
#define PG8_LDA(dst, b, h) do { _Pragma("unroll") for (int m = 0; m < 4; ++m) _Pragma("unroll") for (int k = 0; k < 2; ++k) dst[m][k] = *(const LAS bf16x8*)(lds + PG8_SA(b, h) + aoff + m * 2048 + k * 1024); } while (0)
#define PG8_LDB(dst, b, h) do { _Pragma("unroll") for (int n = 0; n < 2; ++n) _Pragma("unroll") for (int k = 0; k < 2; ++k) dst[n][k] = *(const LAS bf16x8*)(lds + PG8_SB(b, h) + boff + n * 2048 + k * 1024); } while (0)
#define PG8_MMA(ai, bj, At, Bt) do { __builtin_amdgcn_s_setprio(1); _Pragma("unroll") for (int m = 0; m < 4; ++m) _Pragma("unroll") for (int n = 0; n < 2; ++n) _Pragma("unroll") for (int k = 0; k < 2; ++k) \
        acc[ai][bj][m][n] = __builtin_amdgcn_mfma_f32_16x16x32_bf16(Bt[n][k], At[m][k], acc[ai][bj][m][n], 0, 0, 0); __builtin_amdgcn_s_setprio(0); } while (0)
#define PG8_WAIT_V(n) asm volatile("s_waitcnt vmcnt(" #n ")" ::: "memory")
#define PG8_WAIT_L(n) asm volatile("s_waitcnt lgkmcnt(" #n ")" ::: "memory")
#define PG8_BAR __builtin_amdgcn_s_barrier()
#define PG8_SCHED __builtin_amdgcn_sched_barrier(0)
    Unit cur, nxt; int ui = 0;
    if (!S.next(0, cur)) return;
    f32x4 acc[2][2][4][2];
#pragma unroll
    for (int a = 0; a < 2; ++a)
#pragma unroll
        for (int b = 0; b < 2; ++b)
#pragma unroll
            for (int m = 0; m < 4; ++m)
#pragma unroll
                for (int n = 0; n < 2; ++n) acc[a][b][m][n] = (f32x4){0.f, 0.f, 0.f, 0.f};
    bf16x8 At[4][2], B0[2][2], B1[2][2];
    const char* cA = (const char*)g.A + (size_t)cur.pm * tstepA + (size_t)cur.pn * acolb; const char* cB = (const char*)g.Bt + (size_t)cur.pn * tstepB;
    PG8_STAGE(PG8_SB(0, 0), cB, voffB); PG8_STAGE(PG8_SA(0, 0), cA, voffA); PG8_STAGE(PG8_SB(0, 1), cB + hstepB, voffB); PG8_STAGE(PG8_SA(0, 1), cA + hstepA, voffA);
    if (wr == 1) PG8_BAR;
    PG8_WAIT_V(4); PG8_BAR;
    PG8_STAGE(PG8_SB(1, 0), cB + kstep, voffB); PG8_STAGE(PG8_SA(1, 0), cA + kstep, voffA); PG8_STAGE(PG8_SB(1, 1), cB + hstepB + kstep, voffB);
    PG8_WAIT_V(6); PG8_BAR;
    for (;;) {
        const bool has_next = S.next(ui + 1, nxt);
        const char* nA = has_next ? (const char*)g.A + (size_t)nxt.pm * tstepA + (size_t)nxt.pn * acolb : cA; const char* nB = has_next ? (const char*)g.Bt + (size_t)nxt.pn * tstepB : cB;
        for (int t = 0; t < nt; t += 2) {
            const bool last = (t == nt - 2);
            const char* a1 = cA + (size_t)(t + 1) * kstep;
            const char* a2 = last ? nA : cA + (size_t)(t + 2) * kstep; const char* b2 = last ? nB : cB + (size_t)(t + 2) * kstep;
            const char* a3 = a2 + kstep; const char* b3 = b2 + kstep;
            PG8_LDB(B0, 0, 0); PG8_SCHED; PG8_LDA(At, 0, 0); PG8_STAGE(PG8_SA(1, 1), a1 + hstepA, voffA);
            PG8_WAIT_L(8); PG8_BAR; PG8_WAIT_L(0); PG8_MMA(0, 0, At, B0); PG8_BAR; PG8_SCHED;
            PG8_LDB(B1, 0, 1); PG8_STAGE(PG8_SB(0, 0), b2, voffB);
            PG8_BAR; PG8_WAIT_L(0); PG8_MMA(0, 1, At, B1); PG8_BAR;
            PG8_LDA(At, 0, 1); PG8_STAGE(PG8_SA(0, 0), a2, voffA);
            PG8_BAR; PG8_WAIT_L(0); PG8_MMA(1, 0, At, B0); PG8_BAR; PG8_SCHED;
            PG8_STAGE(PG8_SB(0, 1), b2 + hstepB, voffB);
            PG8_WAIT_V(6); PG8_BAR; PG8_MMA(1, 1, At, B1); PG8_BAR;
            PG8_LDB(B0, 1, 0); PG8_SCHED; PG8_LDA(At, 1, 0); PG8_STAGE(PG8_SA(0, 1), a2 + hstepA, voffA);
            PG8_WAIT_L(8); PG8_BAR; PG8_WAIT_L(0); PG8_MMA(0, 0, At, B0); PG8_BAR; PG8_SCHED;
            PG8_LDB(B1, 1, 1); PG8_STAGE(PG8_SB(1, 0), b3, voffB);
            PG8_BAR; PG8_WAIT_L(0); PG8_MMA(0, 1, At, B1); PG8_BAR;
            PG8_LDA(At, 1, 1); PG8_STAGE(PG8_SA(1, 0), a3, voffA);
            PG8_BAR; PG8_WAIT_L(0); PG8_MMA(1, 0, At, B0); PG8_BAR; PG8_SCHED;
            PG8_STAGE(PG8_SB(1, 1), b3 + hstepB, voffB);
            PG8_WAIT_V(6); PG8_BAR; PG8_MMA(1, 1, At, B1); PG8_BAR;
        }
        E(acc, cur, wr, wc, fr, fq);
        if (!has_next) break;
#pragma unroll
        for (int a = 0; a < 2; ++a)
#pragma unroll
            for (int b = 0; b < 2; ++b)
#pragma unroll
                for (int m = 0; m < 4; ++m)
#pragma unroll
                    for (int n = 0; n < 2; ++n) acc[a][b][m][n] = (f32x4){0.f, 0.f, 0.f, 0.f};
        cur = nxt; cA = nA; cB = nB; ++ui;
    }
    PG8_WAIT_V(0);
    if (wr == 0) PG8_BAR;
    PG8_BAR;
#undef PG8_SA
#undef PG8_SB
#undef PG8_STAGE
#undef PG8_LDA
#undef PG8_LDB
#undef PG8_MMA
#undef PG8_WAIT_V
#undef PG8_WAIT_L
#undef PG8_BAR
#undef PG8_SCHED
}
}

__device__ __forceinline__ void stat_store(float s, float q, f32x2* ST, int row, int part, int fq) {
    s += __shfl_xor(s, 16); s += __shfl_xor(s, 32); q += __shfl_xor(q, 16); q += __shfl_xor(q, 32);
    if (fq == 0) ST[(size_t)row * 32 + part] = (f32x2){s, q};
}
struct ResSrc { const float* zlo; const float* zhi; const f32x2* mr; const float* lng; const float* lnb; };
struct EpiGlu {
    const float* bias; ResSrc R; const float* mod; float* Z; f32x2* ST;
    __device__ __forceinline__ void operator()(const f32x4 (&acc)[2][2][4][2], const pg8::Unit& u, int wr, int wc, int fr, int fq) const {
        const int cnd = u.pm < 32 ? 0 : 1 + ((u.pm - 32) >> 3);
        const float* xb = u.pm < 32 ? R.zlo : R.zhi; const float* g1 = mod + cnd * 6144 + 2 * 1024;
        int oc[2]; f32x4 bv[2], bg[2], gv[2], la[2], lb_[2];
#pragma unroll
        for (int bj = 0; bj < 2; ++bj) { oc[bj] = (u.pn * 8 + bj * 4 + wc) * 16 + 4 * fq; bv[bj] = *(const f32x4*)(bias + oc[bj]); bg[bj] = *(const f32x4*)(bias + 1024 + oc[bj]); gv[bj] = *(const f32x4*)(g1 + oc[bj]);
            if (R.mr) { la[bj] = ALPHA * *(const f32x4*)(R.lng + oc[bj]); lb_[bj] = ALPHA * *(const f32x4*)(R.lnb + oc[bj]); } else { la[bj] = (f32x4){ALPHA, ALPHA, ALPHA, ALPHA}; lb_[bj] = (f32x4){0.f, 0.f, 0.f, 0.f}; } }
#pragma unroll
        for (int ai = 0; ai < 2; ++ai) {
            f32x4 xr[4][2]; f32x2 mr[4];
#pragma unroll
            for (int m = 0; m < 4; ++m) { const int row = u.pm * 256 + ai * 128 + wr * 64 + m * 16 + fr; mr[m] = R.mr ? R.mr[row] : (f32x2){0.f, 1.f};
#pragma unroll
                for (int bj = 0; bj < 2; ++bj) xr[m][bj] = *(const f32x4*)(xb + (size_t)row * D + oc[bj]); }
#pragma unroll
            for (int m = 0; m < 4; ++m) { const int row = u.pm * 256 + ai * 128 + wr * 64 + m * 16 + fr; float s = 0.f, q = 0.f;
#pragma unroll
                for (int bj = 0; bj < 2; ++bj) { const f32x4 v = acc[ai][bj][m][0] + bv[bj], gt = acc[ai][bj][m][1] + bg[bj]; f32x4 o;
#pragma unroll
                    for (int e = 0; e < 4; ++e) o[e] = v[e] * sigmoidf_(gt[e]);
                    const f32x4 z = ((xr[m][bj] - mr[m].x) * mr[m].y) * la[bj] + lb_[bj] + gv[bj] * o;
                    *(f32x4*)(Z + (size_t)row * D + oc[bj]) = z; s += (z[0] + z[1]) + (z[2] + z[3]); q += (z[0] * z[0] + z[1] * z[1]) + (z[2] * z[2] + z[3] * z[3]); }
                stat_store(s, q, ST, row, u.pn * 4 + wc, fq); }
            asm volatile("" ::: "memory"); }
    }
};
struct EpiFfn1 {
    bf16_t* H;
    __device__ __forceinline__ void operator()(const f32x4 (&acc)[2][2][4][2], const pg8::Unit& u, int wr, int wc, int fr, int fq) const {
#pragma unroll
        for (int ai = 0; ai < 2; ++ai)
#pragma unroll
            for (int m = 0; m < 4; ++m) { const int row = u.pm * 256 + ai * 128 + wr * 64 + m * 16 + fr;
#pragma unroll
                for (int bj = 0; bj < 2; ++bj) { const int oc = (u.pn * 8 + bj * 4 + wc) * 16 + 4 * fq; const f32x4 gt = acc[ai][bj][m][0], up = acc[ai][bj][m][1]; f32x4 h;
#pragma unroll
                    for (int e = 0; e < 4; ++e) h[e] = gt[e] * sigmoidf_(gt[e]) * up[e];
                    u32x2 w; w.x = cvt_pk_bf16(h[0], h[1]); w.y = cvt_pk_bf16(h[2], h[3]); *(u32x2*)(H + (size_t)row * DFF + oc) = w; } }
    }
};
struct EpiRes {
    ResSrc R; const float* mod; int gchunk; const float* scale; float* Z; f32x2* ST; LAS float* colw;
    __device__ __forceinline__ void operator()(const f32x4 (&acc)[2][2][4][2], const pg8::Unit& u, int wr, int wc, int fr, int fq) const {
        const int cnd = u.pm < 32 ? 0 : 1 + ((u.pm - 32) >> 3);
        const float* gp = mod + cnd * 6144 + gchunk * 1024;
        const int col0 = u.pn * 256 + wc * 32 + 4 * fq;
        LAS float* cw = colw + (wr * 4 + wc) * 192;
        { const int lane = fq * 16 + fr;
          if (lane < 48) { const int arr = lane >> 4, idx = lane & 15, bj = idx >> 3, n = (idx >> 2) & 1, q4 = idx & 3; const int col = u.pn * 256 + wc * 32 + bj * 128 + n * 16 + q4 * 4;
              f32x4 v;
              if (arr == 0) { v = *(const f32x4*)(gp + col); if (scale) v *= *(const f32x4*)(scale + col); }
              else if (arr == 1) v = ALPHA * *(const f32x4*)(R.lng + col);
              else v = ALPHA * *(const f32x4*)(R.lnb + col);
              *(LAS f32x4*)(cw + arr * 64 + (bj * 2 + n) * 16 + q4 * 4) = v; }
          asm volatile("s_waitcnt lgkmcnt(0)" ::: "memory"); __builtin_amdgcn_wave_barrier(); }
#pragma unroll
        for (int ai = 0; ai < 2; ++ai)
#pragma unroll
            for (int mh = 0; mh < 2; ++mh) {
                f32x4 xr[2][2][2]; f32x2 mr[2];
#pragma unroll
                for (int m2 = 0; m2 < 2; ++m2) { const int row = u.pm * 256 + ai * 128 + wr * 64 + (mh * 2 + m2) * 16 + fr; mr[m2] = R.mr[row];
#pragma unroll
                    for (int bj = 0; bj < 2; ++bj)
#pragma unroll
                        for (int n = 0; n < 2; ++n) xr[m2][bj][n] = *(const f32x4*)(R.zlo + (size_t)row * D + col0 + bj * 128 + n * 16); }
                float s[2] = {0.f, 0.f}, q[2] = {0.f, 0.f};
#pragma unroll
                for (int bj = 0; bj < 2; ++bj)
#pragma unroll
                    for (int n = 0; n < 2; ++n) { const int col = col0 + bj * 128 + n * 16;
                        const f32x4 gv = *(const LAS f32x4*)(cw + (bj * 2 + n) * 16 + fq * 4), la = *(const LAS f32x4*)(cw + 64 + (bj * 2 + n) * 16 + fq * 4), lb_ = *(const LAS f32x4*)(cw + 128 + (bj * 2 + n) * 16 + fq * 4);
#pragma unroll
                        for (int m2 = 0; m2 < 2; ++m2) { const int m = mh * 2 + m2; const int row = u.pm * 256 + ai * 128 + wr * 64 + m * 16 + fr;
                            const f32x4 z = ((xr[m2][bj][n] - mr[m2].x) * mr[m2].y) * la + lb_ + gv * acc[ai][bj][m][n];
                            *(f32x4*)(Z + (size_t)row * D + col) = z; s[m2] += (z[0] + z[1]) + (z[2] + z[3]); q[m2] += (z[0] * z[0] + z[1] * z[1]) + (z[2] * z[2] + z[3] * z[3]); } }
#pragma unroll
                for (int m2 = 0; m2 < 2; ++m2) stat_store(s[m2], q[m2], ST, u.pm * 256 + ai * 128 + wr * 64 + (mh * 2 + m2) * 16 + fr, u.pn * 4 + wc, fq);
                asm volatile("" ::: "memory"); }
    }
};

__device__ __forceinline__ void first_seam(unsigned char* ws, LAS unsigned char* lds, bool leader) {
    volatile LAS unsigned* xst = (volatile LAS unsigned*)(lds + LDS_ST_OFF);
    if (leader) { xst[0] = 0u; xst[1] = 0u; }
    __syncthreads();
    (void)xcd_barrier_post((unsigned*)(ws + WS_BAR), xst, leader);
}
__device__ __forceinline__ void later_seam(unsigned char* ws, LAS unsigned char* lds, bool leader) {
    XcdBarrier xb; xb.bar = (unsigned*)(ws + WS_BAR); xb.x = xb_xcc_id(); xb.st = (volatile LAS unsigned*)(lds + LDS_ST_OFF);
    xcd_barrier(xb, leader);
}

__global__ void __launch_bounds__(512) mega(Params p) {
    extern __shared__ __attribute__((aligned(16))) unsigned char lds_raw[];
    LAS unsigned char* lds = (LAS unsigned char*)lds_raw;
    cg::grid_group grid = cg::this_grid();
    int ph = 0;
    const int wv_ = __builtin_amdgcn_readfirstlane((int)(threadIdx.x >> 6));
    if (blockIdx.x == 0) for (int i = threadIdx.x; i < XCD_BAR_WORDS; i += 512) ((unsigned*)(p.ws + WS_BAR))[i] = 0u;
#define PHASE_LOCALS const float* mod = (const float*)(p.ws + WS_MOD); float* Z = (float*)(p.ws + WS_Z); f32x2* ST = (f32x2*)(p.ws + WS_ST); bf16_t* Q = (bf16_t*)(p.ws + WS_Q); bf16_t* Hff = (bf16_t*)(p.ws + WS_Y); pg8::StaticOrder S; const float* lmod = mod + layer * 5 * 6144; (void)Z; (void)ST; (void)Q; (void)Hff; (void)lmod; (void)S
#define PHASE(kind, ...) do { if (ph >= p.ph_lo && ph < p.ph_hi) { for (int r_ = 0; r_ <= ((REPMASK >> (kind)) & 1); ++r_) { \
        { const Params& pp_ = p; { Params p = pp_; p.wv = wv_; asm volatile("" : "+s"(p.ws), "+s"(p.out), "+s"(p.wv)); PHASE_LOCALS; __VA_ARGS__; } } \
        if (ph + 1 < p.ph_hi || r_ < ((REPMASK >> (kind)) & 1)) { const bool leader_ = wv_ == 0 && lane_id_() == 0; if (ph == p.ph_lo && r_ == 0) { grid.sync(); first_seam(p.ws, lds, leader_); } else later_seam(p.ws, lds, leader_); } \
    } } ++ph; } while (0)
    { const int layer = 0; (void)layer;
    PHASE(0, phase_w0(p, lds));
    PHASE(1, phase_prep0(p)); }
    for (int layer_ = 0; layer_ < 4; ++layer_) {
        const int layer = opaque_s(layer_);
        const int jj = layer >> 1;
        if ((layer & 1) == 0) {
            PHASE(2, phase_s5(p, jj, 0, lds));
            PHASE(2, phase_s5(p, jj, 1, lds));
            PHASE(4, { pg8::Gemm g{Q, (const bf16_t*)(p.ws + WS_WG) + (size_t)jj * 2048 * 1024, NTOK, 2048, 1024, 1024, 0}; S.init(NTOK, 2048, gridDim.x, opaque_bid());
                    ResSrc R{layer == 0 ? p.in[0] : p.out, layer == 0 ? p.in[1] - (size_t)NCTX * D : p.out, layer == 0 ? nullptr : (const f32x2*)(p.ws + WS_MR2), p.in[8] + ((layer - 1) * 2 + 1) * 1024, p.in[9] + ((layer - 1) * 2 + 1) * 1024};
                    EpiGlu E{p.in[19] + jj * 2048, R, lmod, Z, ST};
                    pg8::gemm_phase(lds, g, S, E, p.wv); });
            PHASE(5, phase_ln(p, layer, 0, 32, 1));
        } else {
            PHASE(6, phase_poolprep(p, layer));
            PHASE(7, { pg8::Gemm g{Q, (const bf16_t*)(p.ws + WS_WP) + (size_t)jj * 4 * 65536, NTOK, 1024, 256, 1024, 256}; S.init(NTOK, 1024, gridDim.x, opaque_bid());
                    ResSrc R{p.out, p.out, (const f32x2*)(p.ws + WS_MR2), p.in[8] + ((layer - 1) * 2 + 1) * 1024, p.in[9] + ((layer - 1) * 2 + 1) * 1024};
                    EpiRes E{R, lmod, 2, p.in[21] + jj * 1024, Z, ST, (LAS float*)(lds + LDS_COL_OFF)};
                    pg8::gemm_phase(lds, g, S, E, p.wv); });
            PHASE(5, phase_ln(p, layer, 0, 16, 1));
        }
        PHASE(8, { pg8::Gemm g{Q, (const bf16_t*)(p.ws + WS_W1) + (size_t)layer * NFF1 * 1024, NTOK, NFF1, 1024, 1024, 0}; S.init(NTOK, NFF1, gridDim.x, opaque_bid());
                EpiFfn1 E{Hff}; pg8::gemm_phase(lds, g, S, E, p.wv); if (layer < 3) deferred_weights(p, lds, layer + 1, (NTOK / 256) * (NFF1 / 256)); });
        PHASE(9, { pg8::Gemm g{Hff, (const bf16_t*)(p.ws + WS_W2) + (size_t)layer * 1024 * DFF, NTOK, 1024, DFF, DFF, 0}; S.init(NTOK, 1024, gridDim.x, opaque_bid());
                ResSrc R{Z, Z, (const f32x2*)(p.ws + WS_MR1), p.in[8] + (layer * 2) * 1024, p.in[9] + (layer * 2) * 1024};
                EpiRes E{R, lmod, 5, nullptr, p.out, ST, (LAS float*)(lds + LDS_COL_OFF)}; pg8::gemm_phase(lds, g, S, E, p.wv); });
        PHASE(10, phase_ln(p, layer, 1, 16, layer == 3 ? 2 : (layer == 1 ? 1 : 0)));
    }
#undef PHASE
}

extern "C" void kernel_launch(void* const* d_in, const int* in_sizes, int n_in, void* d_out, int out_size, void* d_ws, size_t ws_size, hipStream_t stream) {
    static int grid_blocks = 0;
    if (grid_blocks == 0) {
        if (n_in != 25 || ws_size < WS_END) { fprintf(stderr, "kernel_launch: unexpected n_in %d or ws_size %zu (< %zu)\n", n_in, ws_size, (size_t)WS_END); grid_blocks = -1; return; }
        int dev = 0, cus = 0, per_cu = 0;
        hipGetDevice(&dev);
        hipDeviceGetAttribute(&cus, hipDeviceAttributeMultiprocessorCount, dev);
        if (hipFuncSetAttribute((const void*)mega, hipFuncAttributeMaxDynamicSharedMemorySize, LDS_BYTES) != hipSuccess) { fprintf(stderr, "kernel_launch: hipFuncSetAttribute failed\n"); grid_blocks = -1; return; }
        if (hipOccupancyMaxActiveBlocksPerMultiprocessor(&per_cu, (const void*)mega, 512, LDS_BYTES) != hipSuccess || per_cu < 1) { fprintf(stderr, "kernel_launch: occupancy query failed (%d)\n", per_cu); (void)hipGetLastError(); per_cu = 1; }
        if (per_cu > 1) per_cu = 1;
        grid_blocks = cus * per_cu;
    }
    if (grid_blocks < 0) return;
    Params p{};
    for (int i = 0; i < 25; ++i) p.in[i] = (const float*)d_in[i];
    p.out = (float*)d_out; p.ws = (unsigned char*)d_ws;
#if MULTI_LAUNCH
    for (int ph = 0; ph < NPH; ++ph) { p.ph_lo = ph; p.ph_hi = ph + 1; hipLaunchKernelGGL(mega, dim3(grid_blocks), dim3(512), LDS_BYTES, stream, p); }
#else
    p.ph_lo = 0; p.ph_hi = NPH;
    void* args[] = {&p};
    hipError_t e = hipLaunchCooperativeKernel((const void*)mega, dim3(grid_blocks), dim3(512), args, LDS_BYTES, stream);
    if (e != hipSuccess) fprintf(stderr, "cooperative launch failed: %s (grid %d)\n", hipGetErrorString(e), grid_blocks);
#endif
}
```
